# Optimizing an MI355X kernel written in HIP

```python
import math
import jax
import jax.numpy as jnp
from jax import lax
import numpy as np

D_MODEL = 1024
BATCH = 16
SEQ = 2048
DEPTH = 2

GRID_W = 64
CTX_LEN = 256
N_HEADS = 8
HEAD_DIM = 64
V_HEAD_DIM = 2 * HEAD_DIM
ATTN_WIDTH = N_HEADS * V_HEAD_DIM
N_FOURIER_GROUPS = 4
FOURIER_GROUP_DIM = 128
FOURIER_WIDTH = N_FOURIER_GROUPS * FOURIER_GROUP_DIM
N_BRANCHES = 2
KV_COLS = 2 * ATTN_WIDTH
IN_WIDTH = 3 * ATTN_WIDTH + FOURIER_WIDTH + N_BRANCHES * D_MODEL
D_FF = -(-8 * D_MODEL // (3 * 256)) * 256
N_MOD = 6
ROPE_THETA = 10000.0
Q_BLOCK = 128
EPS = 1e-6

kernel_name = "hybrid_diffattn_fourier_dit"


def rmsnorm(x, g):
    xf = x.astype(jnp.float32)
    y = xf * lax.rsqrt(jnp.mean(xf * xf, axis=-1, keepdims=True) + EPS)
    return (y * g.astype(jnp.float32)).astype(x.dtype)


def modulate(h, shift, scale):
    return h * (1 + scale) + shift


def axial_rope_tables(n_tokens):
    rows = n_tokens // GRID_W
    r, col = jnp.meshgrid(jnp.arange(rows), jnp.arange(GRID_W), indexing="ij")
    r = r.reshape(-1).astype(jnp.float32)
    col = col.reshape(-1).astype(jnp.float32)
    axis_dim = HEAD_DIM // 2
    inv_freq = ROPE_THETA ** (-jnp.arange(0, axis_dim, 2, dtype=jnp.float32) / axis_dim)
    ang_r = r[:, None] * inv_freq[None, :]
    ang_c = col[:, None] * inv_freq[None, :]
    ang = jnp.concatenate([ang_r, ang_r, ang_c, ang_c], axis=-1)
    return jnp.cos(ang), jnp.sin(ang)


def rotate_half_axial(x):
    shp = x.shape
    xs = x.reshape(shp[:-1] + (2, 2, HEAD_DIM // 4))
    return jnp.stack([-xs[..., 1, :], xs[..., 0, :]], axis=-2).reshape(shp)


def apply_rope(x, cos, sin):
    cos = cos[None, :, None, None, :].astype(x.dtype)
    sin = sin[None, :, None, None, :].astype(x.dtype)
    return x * cos + rotate_half_axial(x) * sin


def diff_attention(q, k, v, lam):
    s = jnp.einsum("bqhid,bkhid->bhiqk", q.astype(jnp.float32), k.astype(jnp.float32)) * (HEAD_DIM ** -0.5)
    p = jax.nn.softmax(s, axis=-1)
    a = p[:, :, 0] - lam * p[:, :, 1]
    return jnp.einsum("bhqk,bkhe->bqhe", a, v.astype(jnp.float32)).astype(v.dtype)


def fourier_mix(f):
    b, t, _ = f.shape
    fg = f.reshape(b, t, N_FOURIER_GROUPS, FOURIER_GROUP_DIM).astype(jnp.float32)
    out = jnp.fft.fft2(fg, axes=(1, 3), norm="ortho").real
    return out.reshape(b, t, FOURIER_WIDTH).astype(f.dtype)


def swiglu(h, w_gate_up, w_down):
    gu = h @ w_gate_up
    return (jax.nn.silu(gu[..., :D_FF]) * gu[..., D_FF:]) @ w_down


def trunk_layer(x, cx, mod_lat, mod_ctx, cos, sin, lp, lam_init, ctx_out):
    b, t, _ = x.shape
    tc = cx.shape[1]
    sh1, sc1, gt1, sh2, sc2, gt2 = jnp.split(mod_lat, N_MOD, axis=-1)
    csh1, csc1, cgt1, csh2, csc2, cgt2 = jnp.split(mod_ctx, N_MOD, axis=-1)
    f32 = jnp.float32
    lam = (jnp.exp(jnp.sum(lp["lambda_q1"].astype(f32) * lp["lambda_k1"].astype(f32)))
           - jnp.exp(jnp.sum(lp["lambda_q2"].astype(f32) * lp["lambda_k2"].astype(f32))) + lam_init)

    def kv_heads(p, n):
        k = rmsnorm(p[..., :ATTN_WIDTH].reshape(b, n, N_HEADS, 2, HEAD_DIM), lp["k_norm_g"])
        v = p[..., ATTN_WIDTH:KV_COLS].reshape(b, n, N_HEADS, V_HEAD_DIM)
        return k, v

    def q_heads(p, n):
        return rmsnorm(p[..., KV_COLS:KV_COLS + ATTN_WIDTH].reshape(b, n, N_HEADS, 2, HEAD_DIM), lp["q_norm_g"])

    def merged_branches(attn_o, p_rest):
        n = attn_o.shape[1]
        o = rmsnorm(attn_o, lp["subln_g"]) * (1 - lam_init)
        y_a = o.reshape(b, n, ATTN_WIDTH) @ lp["w_proj_attn"]
        y_f = fourier_mix(p_rest[..., :FOURIER_WIDTH]) @ lp["w_proj_fourier"]
        g_a = jax.nn.sigmoid(p_rest[..., FOURIER_WIDTH:FOURIER_WIDTH + D_MODEL])
        g_f = jax.nn.sigmoid(p_rest[..., FOURIER_WIDTH + D_MODEL:])
        return (g_a * y_a + g_f * y_f) @ lp["w_out"]

    w_in = lp["w_in"]
    h = modulate(rmsnorm(x, lp["norm1_g"]), sh1, sc1)
    hc = modulate(rmsnorm(cx, lp["norm1_g"]), csh1, csc1)
    p = h @ w_in
    pc = hc @ (w_in if ctx_out else w_in[:, :KV_COLS])

    k, v = kv_heads(p, t)
    kc, vc = kv_heads(pc, tc)
    q = apply_rope(q_heads(p, t), cos, sin)
    k = apply_rope(k, cos, sin)
    k_all = jnp.concatenate([kc, k], axis=1)
    v_all = jnp.concatenate([vc, v], axis=1)
    n_blocks = t // Q_BLOCK
    qb = q.reshape(b, n_blocks, Q_BLOCK, N_HEADS, 2, HEAD_DIM).swapaxes(0, 1)
    ob = lax.map(lambda qi: diff_attention(qi, k_all, v_all, lam), qb)
    o = ob.swapaxes(0, 1).reshape(b, t, N_HEADS, V_HEAD_DIM)
    x = x + gt1 * merged_branches(o, p[..., KV_COLS + ATTN_WIDTH:])

    h2 = modulate(rmsnorm(x, lp["norm2_g"]), sh2, sc2)
    x = x + gt2 * swiglu(h2, lp["w_gate_up"], lp["w_down"])

    if not ctx_out:
        return x, cx

    oc = diff_attention(q_heads(pc, tc), kc, vc, lam)
    cx = cx + cgt1 * merged_branches(oc, pc[..., KV_COLS + ATTN_WIDTH:])
    hc2 = modulate(rmsnorm(cx, lp["norm2_g"]), csh2, csc2)
    cx = cx + cgt2 * swiglu(hc2, lp["w_gate_up"], lp["w_down"])
    return x, cx


def setup_inputs(seed: int = 0) -> dict:
    key = jax.random.key(seed)
    ks = jax.random.split(key, 21)

    def nrm(k, shape, scale):
        return jax.random.normal(k, shape, jnp.float32) * scale

    def gain(k, shape):
        return 1.0 + 0.02 * jax.random.normal(k, shape, jnp.float32)

    return {
        "x": nrm(ks[0], (BATCH, SEQ, D_MODEL), 1.0),
        "c": nrm(ks[1], (BATCH, D_MODEL), 1.0),
        "ctx": nrm(ks[2], (BATCH, CTX_LEN, D_MODEL), 1.0),
        "c_ctx": nrm(ks[3], (D_MODEL,), 1.0),
        "w_ada": nrm(ks[4], (DEPTH, D_MODEL, N_MOD * D_MODEL), D_MODEL ** -0.5),
        "b_ada": nrm(ks[5], (DEPTH, N_MOD * D_MODEL), 0.01),
        "norm1_g": gain(ks[6], (DEPTH, D_MODEL)),
        "norm2_g": gain(ks[7], (DEPTH, D_MODEL)),
        "w_in": nrm(ks[8], (DEPTH, D_MODEL, IN_WIDTH), D_MODEL ** -0.5),
        "q_norm_g": gain(ks[9], (DEPTH, HEAD_DIM)),
        "k_norm_g": gain(ks[10], (DEPTH, HEAD_DIM)),
        "lambda_q1": nrm(ks[11], (DEPTH, HEAD_DIM), 0.1),
        "lambda_k1": nrm(ks[12], (DEPTH, HEAD_DIM), 0.1),
        "lambda_q2": nrm(ks[13], (DEPTH, HEAD_DIM), 0.1),
        "lambda_k2": nrm(ks[14], (DEPTH, HEAD_DIM), 0.1),
        "subln_g": gain(ks[15], (DEPTH, V_HEAD_DIM)),
        "w_proj_attn": nrm(ks[16], (DEPTH, ATTN_WIDTH, D_MODEL), ATTN_WIDTH ** -0.5),
        "w_proj_fourier": nrm(ks[17], (DEPTH, FOURIER_WIDTH, D_MODEL), FOURIER_WIDTH ** -0.5),
        "w_out": nrm(ks[18], (DEPTH, D_MODEL, D_MODEL), D_MODEL ** -0.5),
        "w_gate_up": nrm(ks[19], (DEPTH, D_MODEL, 2 * D_FF), D_MODEL ** -0.5),
        "w_down": nrm(ks[20], (DEPTH, D_FF, D_MODEL), D_FF ** -0.5),
    }


def reference(x, c, ctx, c_ctx, w_ada, b_ada, norm1_g, norm2_g, w_in, q_norm_g, k_norm_g,
              lambda_q1, lambda_k1, lambda_q2, lambda_k2, subln_g, w_proj_attn, w_proj_fourier,
              w_out, w_gate_up, w_down):
    cos, sin = axial_rope_tables(x.shape[1])
    silu_c = jax.nn.silu(c)
    silu_cc = jax.nn.silu(c_ctx)
    cx = ctx
    for l in range(DEPTH):
        lp = {
            "norm1_g": norm1_g[l], "norm2_g": norm2_g[l], "w_in": w_in[l],
            "q_norm_g": q_norm_g[l], "k_norm_g": k_norm_g[l],
            "lambda_q1": lambda_q1[l], "lambda_k1": lambda_k1[l],
            "lambda_q2": lambda_q2[l], "lambda_k2": lambda_k2[l],
            "subln_g": subln_g[l], "w_proj_attn": w_proj_attn[l],
            "w_proj_fourier": w_proj_fourier[l], "w_out": w_out[l],
            "w_gate_up": w_gate_up[l], "w_down": w_down[l],
        }
        mod_lat = (silu_c @ w_ada[l] + b_ada[l])[:, None, :]
        mod_ctx = (silu_cc @ w_ada[l] + b_ada[l])[None, None, :]
        lam_init = 0.8 - 0.6 * math.exp(-0.3 * l)
        x, cx = trunk_layer(x, cx, mod_lat, mod_ctx, cos, sin, lp, lam_init, l < DEPTH - 1)
    return x
```

```cpp
#define MK_SP2 true
#define MK_ALIGN true
#include <hip/hip_runtime.h>
#include <hip/hip_cooperative_groups.h>
#include <hip/hip_bf16.h>
#include <cstdio>
#include <cstdint>
namespace cg = cooperative_groups;
#ifndef MK_COOP
#define MK_COOP 1
#endif
__device__ __forceinline__ int mk_lane() { return (int)__builtin_amdgcn_mbcnt_hi(~0u, __builtin_amdgcn_mbcnt_lo(~0u, 0u)) & 63; }
namespace pg8 {
#define PG8_LAS __attribute__((address_space(3)))
typedef unsigned short bf16_t;
typedef short bf16x8 __attribute__((ext_vector_type(8)));
typedef float f32x4 __attribute__((ext_vector_type(4)));
typedef unsigned u32x4 __attribute__((ext_vector_type(4)));
constexpr int BM = 256, BK = 64, HALF = 128, HTB = HALF * BK * 2  , STAGE_BYTES = 8 * HTB, NXCD = 8, WGM = 8;

__host__ __device__ __forceinline__ int lds_byte(int r, int c) { const int st = (r >> 4) * 2 + (c >> 5), rr = r & 15, cc = c & 31, ob = rr * 64 + cc * 2; return st * 1024 + (ob ^ (((ob >> 9) & 1) << 5)); }
__host__ __device__ __forceinline__ void stage_rc(int b, int& R, int& C) { const int st = b / 1024, sb = b % 1024, swz = sb ^ (((sb >> 9) & 1) << 5); R = (st >> 1) * 16 + swz / 64; C = (st & 1) * 32 + (swz % 64) / 2; }
__host__ __device__ __forceinline__ int perm32(int rho) { const int n = rho >> 4, i = rho & 15; return 8 * (i >> 2) + 4 * n + (i & 3); }

struct Unit { int pm, pn; };
struct Gemm { const bf16_t* A; const bf16_t* Bt; int M, N, K; int ld; };

struct StaticOrder {
    int nM, nN, nwg, G, c;
    __host__ __device__ void init(int M, int N, int G_, int c_) { nM = M / BM; nN = N / BM; nwg = nM * nN; G = G_; c = c_; }
    __host__ __device__ bool next(int i, Unit& u) const {
        const long L = (long)i * G + c; if (L >= nwg) return false;
        int wgid = (int)L; { const int q = nwg / NXCD, r = nwg % NXCD, xcd = wgid % NXCD, off = wgid / NXCD; wgid = (xcd < r ? xcd * (q + 1) : r * (q + 1) + (xcd - r) * q) + off; }
        const int nig = WGM * nN, gid = wgid / nig, fm = gid * WGM, gsz = (nM - fm) < WGM ? (nM - fm) : WGM;
        u.pm = fm + ((wgid % nig) % gsz); u.pn = (wgid % nig) / gsz; return true;
    }
    __device__ __forceinline__ void a_ready(const Unit&) const {}
    __device__ __forceinline__ void done(const Unit&) const {}
};
__device__ __forceinline__ unsigned cvt_pk_bf16(float lo, float hi) { unsigned r; asm volatile("v_cvt_pk_bf16_f32 %0, %1, %2" : "=v"(r) : "v"(lo), "v"(hi)); return r; }
typedef float f32x2 __attribute__((ext_vector_type(2)));
template <class Epi, class Sched, bool ALIGN_EPI = false, bool SP2 = false, int BMODE = 0>
__device__ __forceinline__ void gemm_phase(PG8_LAS unsigned char* lds, const Gemm g, const Sched& S, const Epi& E, const int wave_s_) {
    int tid_ = threadIdx.x; asm volatile("" : "+v"(tid_));
    const int tid = tid_, wid = __builtin_amdgcn_readfirstlane(tid >> 6), lane = tid & 63, wr = wid >> 2, wc = wid & 3, fr = lane & 15, fq = lane >> 4;
    const int K = g.K, nt = K / BK, LD = g.ld ? g.ld : g.K;
    unsigned voffA[2], voffB[2]; int voffBh[2];
#pragma unroll
    for (int i = 0; i < 2; ++i) { int R, C; stage_rc(tid * 16 + i * 8192, R, C); const int Rb = Epi::PERM ? ((R & ~31) + perm32(R & 31)) : R;
        voffA[i] = (unsigned)(R * LD + C) * 2u; voffB[i] = (unsigned)(Rb * LD + C) * 2u; voffBh[i] = BMODE ? (C - Rb * LD) * 2 : (int)voffB[i]; }
    const size_t kstep = (size_t)(BK * 2);
    const size_t hstep = (size_t)HALF * LD * 2;
    const size_t tstep = 2 * hstep;
#define PG8_B0(pn_) (BMODE ? (const char*)g.Bt + (size_t)(((pn_) >> 3) * 2048 + ((pn_) & 7) * 128) * K * 2 : (const char*)g.Bt + (size_t)(pn_) * tstep)
#define PG8_B1(pn_, b0_) (BMODE ? (const char*)g.Bt + (size_t)(((pn_) >> 3) * 2048 + 2048 - ((pn_) & 7) * 128) * K * 2 : (b0_) + hstep)
    const unsigned ldsw = (unsigned)wid * 1024u;
    const int aoff = lds_byte(wr * 64 + fr, fq * 8), boff = lds_byte(wc * 32 + fr, fq * 8);
#define PG8_SA(b, h) (((b) * 2 + (h)) * HTB)
#define PG8_SB(b, h) ((4 + (b) * 2 + (h)) * HTB)
#define PG8_STAGE(bufoff, gbase, voff) do { _Pragma("unroll") for (int _i = 0; _i < 2; ++_i) \
        __builtin_amdgcn_global_load_lds((const unsigned*)((const char*)(gbase) + (voff)[_i]), (PG8_LAS unsigned*)(lds + (bufoff) + ldsw + _i * 8192), 16, 0, 0); } while (0)
#define PG8_LDA(dst, b, h) do { _Pragma("unroll") for (int m = 0; m < 4; ++m) _Pragma("unroll") for (int k = 0; k < 2; ++k) dst[m][k] = *(const PG8_LAS bf16x8*)(lds + PG8_SA(b, h) + aoff + m * 2048 + k * 1024); } while (0)
#define PG8_LDB(dst, b, h) do { _Pragma("unroll") for (int n = 0; n < 2; ++n) _Pragma("unroll") for (int k = 0; k < 2; ++k) dst[n][k] = *(const PG8_LAS bf16x8*)(lds + PG8_SB(b, h) + boff + n * 2048 + k * 1024); } while (0)
#define PG8_MMA(ai, bj, At, Bt) do { __builtin_amdgcn_s_setprio(1); _Pragma("unroll") for (int m = 0; m < 4; ++m) _Pragma("unroll") for (int n = 0; n < 2; ++n) _Pragma("unroll") for (int k = 0; k < 2; ++k) \
        acc[ai][bj][m][n] = __builtin_amdgcn_mfma_f32_16x16x32_bf16(Bt[n][k], At[m][k], acc[ai][bj][m][n], 0, 0, 0); __builtin_amdgcn_s_setprio(0); } while (0)
#define PG8_WAIT_V(n) asm volatile("s_waitcnt vmcnt(" #n ")" ::: "memory")
#define PG8_WAIT_L(n) asm volatile("s_waitcnt lgkmcnt(" #n ")" ::: "memory")
#define PG8_BAR __builtin_amdgcn_s_barrier()
#define PG8_SCHED __builtin_amdgcn_sched_barrier(0)
    Unit cur, nxt; int ui = 0;
    if (!S.next(0, cur)) return;
    f32x4 acc[2][2][4][2];
#pragma unroll
    for (int a = 0; a < 2; ++a)
#pragma unroll
        for (int b = 0; b < 2; ++b)
#pragma unroll
            for (int m = 0; m < 4; ++m)
#pragma unroll
                for (int n = 0; n < 2; ++n) acc[a][b][m][n] = (f32x4){0.f, 0.f, 0.f, 0.f};
    bf16x8 At[4][2], B0[2][2], B1[2][2];
    const char* cA = (const char*)g.A + (size_t)cur.pm * tstep; const char* cB = PG8_B0(cur.pn); const char* cBh = PG8_B1(cur.pn, cB);
    S.a_ready(cur);
    if constexpr (SP2) {
        PG8_STAGE(PG8_SB(0, 0), cB, voffB); PG8_STAGE(PG8_SB(0, 1), cBh, voffBh); PG8_STAGE(PG8_SA(0, 0), cA, voffA); PG8_STAGE(PG8_SA(0, 1), cA + hstep, voffA);
        if (wr == 1) PG8_BAR;
        PG8_WAIT_V(2); PG8_BAR;
        PG8_STAGE(PG8_SB(1, 0), cB + kstep, voffB); PG8_STAGE(PG8_SA(1, 0), cA + kstep, voffA); PG8_STAGE(PG8_SB(1, 1), cBh + kstep, voffBh);
        PG8_WAIT_V(6); PG8_BAR;
    } else {
        PG8_STAGE(PG8_SB(0, 0), cB, voffB); PG8_STAGE(PG8_SA(0, 0), cA, voffA); PG8_STAGE(PG8_SB(0, 1), cBh, voffBh); PG8_STAGE(PG8_SA(0, 1), cA + hstep, voffA);
        if (wr == 1) PG8_BAR;
        PG8_WAIT_V(4); PG8_BAR;
        PG8_STAGE(PG8_SB(1, 0), cB + kstep, voffB); PG8_STAGE(PG8_SA(1, 0), cA + kstep, voffA); PG8_STAGE(PG8_SB(1, 1), cBh + kstep, voffBh);
        PG8_WAIT_V(6); PG8_BAR;
    }
    for (;;) {
        const bool has_next = S.next(ui + 1, nxt);
        const char* nA = has_next ? (const char*)g.A + (size_t)nxt.pm * tstep : cA; const char* nB = has_next ? PG8_B0(nxt.pn) : cB; const char* nBh = has_next ? PG8_B1(nxt.pn, nB) : cBh;
        for (int t = 0; t < nt; t += 2) {
            const bool last = (t == nt - 2);
            const char* a1 = cA + (size_t)(t + 1) * kstep;
            const char* a2 = last ? nA : cA + (size_t)(t + 2) * kstep; const char* b2 = last ? nB : cB + (size_t)(t + 2) * kstep;
            const char* a3 = a2 + kstep; const char* b3 = b2 + kstep; const char* b2h = last ? nBh : cBh + (size_t)(t + 2) * kstep; const char* b3h = b2h + kstep;
            if (last && has_next) S.a_ready(nxt);
            if constexpr (SP2) {
            PG8_LDB(B0, 0, 0); PG8_LDB(B1, 0, 1); PG8_SCHED; PG8_LDA(At, 0, 0); PG8_STAGE(PG8_SA(1, 1), a1 + hstep, voffA);
            PG8_WAIT_V(8); PG8_WAIT_L(0); PG8_BAR; PG8_MMA(0, 0, At, B0); PG8_MMA(0, 1, At, B1); PG8_BAR; PG8_SCHED;
            PG8_LDA(At, 0, 1); PG8_STAGE(PG8_SB(0, 0), b2, voffB); PG8_STAGE(PG8_SB(0, 1), b2h, voffBh); PG8_STAGE(PG8_SA(0, 0), a2, voffA);
            PG8_WAIT_V(8); PG8_WAIT_L(0); PG8_BAR; PG8_MMA(1, 0, At, B0); PG8_MMA(1, 1, At, B1); PG8_BAR; PG8_SCHED;
            PG8_LDB(B0, 1, 0); PG8_LDB(B1, 1, 1); PG8_SCHED; PG8_LDA(At, 1, 0); PG8_STAGE(PG8_SA(0, 1), a2 + hstep, voffA);
            PG8_WAIT_V(8); PG8_WAIT_L(0); PG8_BAR; PG8_MMA(0, 0, At, B0); PG8_MMA(0, 1, At, B1); PG8_BAR; PG8_SCHED;
            PG8_LDA(At, 1, 1); PG8_STAGE(PG8_SB(1, 0), b3, voffB); PG8_STAGE(PG8_SB(1, 1), b3h, voffBh); PG8_STAGE(PG8_SA(1, 0), a3, voffA);
            PG8_WAIT_V(8); PG8_WAIT_L(0); PG8_BAR; PG8_MMA(1, 0, At, B0); PG8_MMA(1, 1, At, B1); PG8_BAR; PG8_SCHED;
            } else {
            PG8_LDB(B0, 0, 0); PG8_SCHED; PG8_LDA(At, 0, 0); PG8_STAGE(PG8_SA(1, 1), a1 + hstep, voffA);
            PG8_WAIT_L(8); PG8_BAR; PG8_WAIT_L(0); PG8_MMA(0, 0, At, B0); PG8_BAR; PG8_SCHED;
            PG8_LDB(B1, 0, 1); PG8_STAGE(PG8_SB(0, 0), b2, voffB);
            PG8_BAR; PG8_WAIT_L(0); PG8_MMA(0, 1, At, B1); PG8_BAR;
            PG8_LDA(At, 0, 1); PG8_STAGE(PG8_SA(0, 0), a2, voffA);
            PG8_BAR; PG8_WAIT_L(0); PG8_MMA(1, 0, At, B0); PG8_BAR; PG8_SCHED;
            PG8_STAGE(PG8_SB(0, 1), b2h, voffBh);
            PG8_WAIT_V(6); PG8_BAR; PG8_MMA(1, 1, At, B1); PG8_BAR;
            PG8_LDB(B0, 1, 0); PG8_SCHED; PG8_LDA(At, 1, 0); PG8_STAGE(PG8_SA(0, 1), a2 + hstep, voffA);
            PG8_WAIT_L(8); PG8_BAR; PG8_WAIT_L(0); PG8_MMA(0, 0, At, B0); PG8_BAR; PG8_SCHED;
            PG8_LDB(B1, 1, 1); PG8_STAGE(PG8_SB(1, 0), b3, voffB);
            PG8_BAR; PG8_WAIT_L(0); PG8_MMA(0, 1, At, B1); PG8_BAR;
            PG8_LDA(At, 1, 1); PG8_STAGE(PG8_SA(1, 0), a3, voffA);
            PG8_BAR; PG8_WAIT_L(0); PG8_MMA(1, 0, At, B0); PG8_BAR; PG8_SCHED;
            PG8_STAGE(PG8_SB(1, 1), b3h, voffBh);
            PG8_WAIT_V(6); PG8_BAR; PG8_MMA(1, 1, At, B1); PG8_BAR;
            }
        }
        if constexpr (ALIGN_EPI) { if (wr == 0) PG8_BAR; }
        if constexpr (!Epi::AFTER_DRAIN) { E(acc, cur, wr, wc, fr, fq); S.done(cur); }
        if (!has_next) break;
#pragma unroll
        for (int a = 0; a < 2; ++a)
#pragma unroll
            for (int b = 0; b < 2; ++b)
#pragma unroll
                for (int m = 0; m < 4; ++m)
#pragma unroll
                    for (int n = 0; n < 2; ++n) acc[a][b][m][n] = (f32x4){0.f, 0.f, 0.f, 0.f};
        cur = nxt; cA = nA; cB = nB; cBh = nBh; ++ui;
        if constexpr (ALIGN_EPI) { if (wr == 1) PG8_BAR; }
    }
    PG8_WAIT_V(0);
    if constexpr (!ALIGN_EPI) { if (wr == 0) PG8_BAR; }
    PG8_BAR;
    if constexpr (Epi::AFTER_DRAIN) { E.fused(acc, cur, wr, wc, fr, fq, lds, wid, lane); S.done(cur); }
#undef PG8_SA
#undef PG8_SB
#undef PG8_STAGE
#undef PG8_LDA
#undef PG8_LDB
#undef PG8_MMA
#undef PG8_WAIT_V
#undef PG8_WAIT_L
#undef PG8_BAR
#undef PG8_SCHED
}
}

constexpr int DM = 1024, NB = 16, SEQ = 2048, CTXL = 256;
constexpr int M_LAT = NB * SEQ, M_CTX = NB * CTXL, M_ALL = M_LAT + M_CTX;
constexpr int DFF = 2816, INW = 5632;
constexpr float EPS = 1e-6f;
constexpr float LOG2E = 1.4426950408889634f;
constexpr float QSCALE = 0.125f * LOG2E;
typedef unsigned short bf16_t;
typedef unsigned u32x4 __attribute__((ext_vector_type(4)));
typedef unsigned u32x2 __attribute__((ext_vector_type(2)));
typedef float f32x4 __attribute__((ext_vector_type(4)));
#define LAS __attribute__((address_space(3)))

constexpr size_t MiB = 1u << 20;
constexpr size_t OFF_LAM = 0, OFF_ROPE = 4096, OFF_XBAR = 16384, OFF_MOD = 65536, CTL_ZERO_BYTES = 1 * MiB;
constexpr size_t WS_W = 1 * MiB, W_LSTRIDE = 34 * MiB;
constexpr size_t W_KVQ = 0, W_G = 6 * MiB, W_F = 10 * MiB, W_PA = 12 * MiB, W_PF = 14 * MiB, W_OUT = 15 * MiB, W_GU = 17 * MiB, W_D = 28 * MiB;
constexpr size_t WS_DFT = 69 * MiB, WS_DFTC = 85 * MiB, WS_RC = 86 * MiB, WS_H = 102 * MiB, WS_Q = 174 * MiB, WS_K = 246 * MiB, WS_V = 318 * MiB;
constexpr size_t WS_YT = 390 * MiB, WS_YTC = 454 * MiB, WS_FM = 462 * MiB, WS_END = 498 * MiB;
constexpr int LDS_BYTES = 147456;
constexpr size_t WS_WFC = WS_DFT + 9 * MiB;
constexpr int ZK = 2176;

typedef float f32x2_t __attribute__((ext_vector_type(2))); typedef __bf16 bf16x2_t __attribute__((ext_vector_type(2)));
__device__ __forceinline__ unsigned pk2(float lo, float hi) { f32x2_t v = {lo, hi}; bf16x2_t b = __builtin_convertvector(v, bf16x2_t); return __builtin_bit_cast(unsigned, b); }
__device__ __forceinline__ float bflo(unsigned w) { return __uint_as_float(w << 16); }
__device__ __forceinline__ float bfhi(unsigned w) { return __uint_as_float(w & 0xffff0000u); }
__device__ __forceinline__ unsigned f2bf(float f) { unsigned u = __float_as_uint(f); return (u + 0x7fffu + ((u >> 16) & 1u)) >> 16; }
__device__ __forceinline__ float fast_exp2(float x) { return __builtin_amdgcn_exp2f(x); }
__device__ __forceinline__ float fast_rcp(float x) { return __builtin_amdgcn_rcpf(x); }
__device__ __forceinline__ float sigmoidf_(float x) { return fast_rcp(1.f + fast_exp2(-x * LOG2E)); }
__device__ __forceinline__ float wave_sum(float v) {
#pragma unroll
    for (int o = 1; o < 64; o <<= 1) v += __shfl_xor(v, o);
    return v;
}

namespace ep {
using pg8::Unit; using pg8::BM; using pg8::HALF;
struct EpiKVQ {
    static constexpr bool PERM = false, AFTER_DRAIN = false;
    bf16_t *Kb, *Vb, *Qb; const LAS float* tab;
    __device__ __forceinline__ void operator()(const f32x4 (&acc)[2][2][4][2], const Unit& u, int wr, int wc, int fr, int fq) const {
        const int sect = u.pn >> 2, pt = u.pn & 3;
        const int row0 = u.pm * BM + wr * 64 + fr;
        if (sect == 1) {
#pragma unroll
            for (int ai = 0; ai < 2; ++ai)
#pragma unroll
                for (int m = 0; m < 4; ++m) { bf16_t* rowp = Vb + (size_t)(row0 + ai * HALF + m * 16) * 1024 + pt * 256 + wc * 32 + 8 * fq;
#pragma unroll
                    for (int bj = 0; bj < 2; ++bj) { const f32x4 v0 = acc[ai][bj][m][0], v1 = acc[ai][bj][m][1];
                        u32x4 w; w.x = pk2(v0[0], v0[1]); w.y = pk2(v0[2], v0[3]); w.z = pk2(v1[0], v1[1]); w.w = pk2(v1[2], v1[3]);
                        *(u32x4*)(rowp + bj * HALF) = w; } }
        } else {
            const LAS float* g = tab + (sect == 0 ? 2048 : 2112); const LAS float* rope = tab; const float osc = sect == 0 ? 1.f : QSCALE; bf16_t* dst = sect == 0 ? Kb : Qb;
            const bool isctx = u.pm >= 128;
#pragma unroll
            for (int ai = 0; ai < 2; ++ai)
#pragma unroll
                for (int m = 0; m < 4; ++m) {
                    const int row = row0 + ai * HALF + m * 16;
                    float ss = 0.f;
#pragma unroll
                    for (int bj = 0; bj < 2; ++bj)
#pragma unroll
                        for (int n = 0; n < 2; ++n) { const f32x4 x = acc[ai][bj][m][n]; ss += (x[0] * x[0] + x[1] * x[1]) + (x[2] * x[2] + x[3] * x[3]); }
                    ss += __shfl_xor(ss, 16); ss += __shfl_xor(ss, 32);
                    const float rinv = rsqrtf(ss * (1.f / 64.f) + EPS) * osc;
                    const int t = row & 2047; const int pos0 = t >> 6, pos1 = t & 63;
                    bf16_t* p = dst + (size_t)row * 1024 + (pt * 4 + wc) * 64 + 16 * fq;
#pragma unroll
                    for (int bj = 0; bj < 2; ++bj) {
                        const f32x4 g0 = *(const LAS f32x4*)(g + 32 * bj + 4 * fq), g1 = *(const LAS f32x4*)(g + 32 * bj + 16 + 4 * fq);
                        f32x4 x1 = acc[ai][bj][m][0] * (g0 * rinv), x2 = acc[ai][bj][m][1] * (g1 * rinv);
                        asm volatile("" : "+v"(x1), "+v"(x2) :: "memory");
#ifndef NO_ROPE
                        if (!isctx) { const int pos = bj == 0 ? pos0 : pos1;
                            const f32x4 c = *(const LAS f32x4*)(rope + pos * 16 + 4 * fq), s = *(const LAS f32x4*)(rope + 1024 + pos * 16 + 4 * fq);
                            const f32x4 y1 = x1 * c - x2 * s, y2 = x2 * c + x1 * s; x1 = y1; x2 = y2; }
#endif
                        u32x4 w; w.x = pk2(x1[0], x1[1]); w.y = pk2(x1[2], x1[3]); w.z = pk2(x2[0], x2[1]); w.w = pk2(x2[2], x2[3]);
                        *(u32x4*)(p + 8 * bj) = w;
                        asm volatile("" ::: "memory");
                    }
                }
        }
    }
};
struct EpiYT {
    static constexpr bool PERM = true, AFTER_DRAIN = false;
    bf16_t *YT, *YTC;
    __device__ __forceinline__ void operator()(const f32x4 (&acc)[2][2][4][2], const Unit& u, int wr, int wc, int fr, int fq) const {
        const bool isctx = u.pn >= 128;
        bf16_t* base = isctx ? YTC + (size_t)(u.pn - 128) * 1024 * 256 : YT + (size_t)(u.pn >> 3) * 1024 * 2048 + (u.pn & 7) * 256;
        const int rs = isctx ? 256 : 2048;
        const int r0 = u.pm * BM + wr * 64 + fr;
#pragma unroll
        for (int ai = 0; ai < 2; ++ai)
#pragma unroll
            for (int m = 0; m < 4; ++m) { bf16_t* rowp = base + (size_t)(r0 + ai * HALF + m * 16) * rs + wc * 32 + 8 * fq;
#pragma unroll
                for (int bj = 0; bj < 2; ++bj) { const f32x4 v0 = acc[ai][bj][m][0], v1 = acc[ai][bj][m][1];
                    u32x4 w; w.x = pk2(v0[0], v0[1]); w.y = pk2(v0[2], v0[3]); w.z = pk2(v1[0], v1[1]); w.w = pk2(v1[2], v1[3]);
                    *(u32x4*)(rowp + bj * HALF) = w; } }
    }
};
struct EpiYTm {
    static constexpr bool PERM = true, AFTER_DRAIN = false;
    bf16_t* Z;
    __device__ __forceinline__ void operator()(const f32x4 (&acc)[2][2][4][2], const Unit& u, int wr, int wc, int fr, int fq) const {
        const int t0 = (u.pn & 7) * 128 + wc * 32 + 8 * fq, cs = fr & 1;
        const int r0 = u.pm * BM + wr * 64 + fr;
        bf16_t* zb = Z + (size_t)((u.pn >> 3) * 512) * ZK + t0;
#pragma unroll
        for (int ai = 0; ai < 2; ++ai)
#pragma unroll
            for (int m = 0; m < 4; ++m) { const int q = (r0 + ai * HALF + m * 16) >> 1, g = q >> 6, cp = q & 63;
                const bool c64 = (cp == 0) && cs;
                const bool costype = !cs || c64;
                const float sgn = costype ? 1.f : -1.f;
                f32x4 za = acc[ai][0][m][0] + acc[ai][1][m][0] * sgn, zc = acc[ai][0][m][1] + acc[ai][1][m][1] * sgn;
                if (t0 == 0 && costype) za[0] = acc[ai][0][m][0][0];
                u32x4 w; w.x = pk2(za[0], za[1]); w.y = pk2(za[2], za[3]); w.z = pk2(zc[0], zc[1]); w.w = pk2(zc[2], zc[3]);
                const int n1 = g * 128 + (cp ? cp : (c64 ? 64 : 0)), p1 = cp ? cs * 1024 : 0;
                const int n2 = cp ? g * 128 + 128 - cp : n1, p2 = cp ? p1 : 1024;
                const unsigned flip = (cp && cs) ? 0x80008000u : 0u, keep = cp ? 0xffffffffu : 0u;
                *(u32x4*)(zb + n1 * ZK + p1) = w;
                asm volatile("" ::: "memory");
                w.x = (w.x ^ flip) & keep; w.y = (w.y ^ flip) & keep; w.z = (w.z ^ flip) & keep; w.w = (w.w ^ flip) & keep;
                *(u32x4*)(zb + n2 * ZK + p2) = w;
                asm volatile("" ::: "memory"); }
    }
};
struct EpiYTc {
    static constexpr bool PERM = true, AFTER_DRAIN = false;
    bf16_t* YTC;
    __device__ __forceinline__ void operator()(const f32x4 (&acc)[2][2][4][2], const Unit& u, int wr, int wc, int fr, int fq) const {
        bf16_t* base = YTC + (size_t)u.pn * 1024 * 256;
        const int r0 = u.pm * BM + wr * 64 + fr;
#pragma unroll
        for (int ai = 0; ai < 2; ++ai)
#pragma unroll
            for (int m = 0; m < 4; ++m) { bf16_t* rowp = base + (size_t)(r0 + ai * HALF + m * 16) * 256 + wc * 32 + 8 * fq;
#pragma unroll
                for (int bj = 0; bj < 2; ++bj) { const f32x4 v0 = acc[ai][bj][m][0], v1 = acc[ai][bj][m][1];
                    u32x4 w; w.x = pk2(v0[0], v0[1]); w.y = pk2(v0[2], v0[3]); w.z = pk2(v1[0], v1[1]); w.w = pk2(v1[2], v1[3]);
                    *(u32x4*)(rowp + bj * HALF) = w; } }
    }
};
struct EpiGate {
    static constexpr bool PERM = false, AFTER_DRAIN = false;
    bf16_t* G;
    __device__ __forceinline__ void operator()(const f32x4 (&acc)[2][2][4][2], const Unit& u, int wr, int wc, int fr, int fq) const {
        const int row0 = u.pm * BM + wr * 64 + fr;
#pragma unroll
        for (int ai = 0; ai < 2; ++ai)
#pragma unroll
            for (int m = 0; m < 4; ++m) { bf16_t* rowp = G + (size_t)(row0 + ai * HALF + m * 16) * 2048 + u.pn * 256 + wc * 32 + 8 * fq;
#pragma unroll
                for (int bj = 0; bj < 2; ++bj) { const f32x4 v0 = acc[ai][bj][m][0], v1 = acc[ai][bj][m][1];
                    u32x4 w; w.x = pk2(sigmoidf_(v0[0]), sigmoidf_(v0[1])); w.y = pk2(sigmoidf_(v0[2]), sigmoidf_(v0[3]));
                    w.z = pk2(sigmoidf_(v1[0]), sigmoidf_(v1[1])); w.w = pk2(sigmoidf_(v1[2]), sigmoidf_(v1[3]));
                    *(u32x4*)(rowp + bj * HALF) = w; } }
    }
};
template <bool ADD> struct EpiMerge {
    static constexpr bool PERM = false, AFTER_DRAIN = false;
    bf16_t* MG; const bf16_t* G; int goff;
    __device__ __forceinline__ void operator()(const f32x4 (&acc)[2][2][4][2], const Unit& u, int wr, int wc, int fr, int fq) const {
        const int row0 = u.pm * BM + wr * 64 + fr; const int col = u.pn * 256 + wc * 32 + 8 * fq;
        u32x4 gc[2], gn[2], oc[2], on[2];
#pragma unroll
        for (int bj = 0; bj < 2; ++bj) { gc[bj] = *(const u32x4*)(G + (size_t)row0 * 2048 + goff + col + bj * HALF); if (ADD) oc[bj] = *(const u32x4*)(MG + (size_t)row0 * 1024 + col + bj * HALF); }
#pragma unroll
        for (int it = 0; it < 8; ++it) { const int ai = it >> 2, m = it & 3; const int row = row0 + ai * HALF + m * 16;
            if (it < 7) { const int rown = row0 + ((it + 1) >> 2) * HALF + ((it + 1) & 3) * 16;
#pragma unroll
                for (int bj = 0; bj < 2; ++bj) { gn[bj] = *(const u32x4*)(G + (size_t)rown * 2048 + goff + col + bj * HALF); if (ADD) on[bj] = *(const u32x4*)(MG + (size_t)rown * 1024 + col + bj * HALF); } }
#pragma unroll
            for (int bj = 0; bj < 2; ++bj) { const f32x4 v0 = acc[ai][bj][m][0], v1 = acc[ai][bj][m][1]; const u32x4 g = gc[bj];
                bf16_t* mp = MG + (size_t)row * 1024 + col + bj * HALF;
                float r[8] = {v0[0] * bflo(g.x), v0[1] * bfhi(g.x), v0[2] * bflo(g.y), v0[3] * bfhi(g.y), v1[0] * bflo(g.z), v1[1] * bfhi(g.z), v1[2] * bflo(g.w), v1[3] * bfhi(g.w)};
                if (ADD) { const u32x4 o = oc[bj];
                    r[0] += bflo(o.x); r[1] += bfhi(o.x); r[2] += bflo(o.y); r[3] += bfhi(o.y); r[4] += bflo(o.z); r[5] += bfhi(o.z); r[6] += bflo(o.w); r[7] += bfhi(o.w); }
                u32x4 w; w.x = pk2(r[0], r[1]); w.y = pk2(r[2], r[3]); w.z = pk2(r[4], r[5]); w.w = pk2(r[6], r[7]);
                *(u32x4*)mp = w; gc[bj] = gn[bj]; if (ADD) oc[bj] = on[bj]; }
            asm volatile("" ::: "memory"); }
    }
};
struct EpiRes {
    static constexpr bool PERM = false, AFTER_DRAIN = false;
    const float *in_lat, *in_ctx; float *out_lat, *out_ctx; const float* gate; float gscale;
    __device__ __forceinline__ void operator()(const f32x4 (&acc)[2][2][4][2], const Unit& u, int wr, int wc, int fr, int fq) const {
        const bool isctx = u.pm >= 128; const int modrow = isctx ? 16 : (u.pm >> 3);
        const float* inb = isctx ? in_ctx - (size_t)M_LAT * 1024 : in_lat; float* outb = isctx ? out_ctx - (size_t)M_LAT * 1024 : out_lat;
        const int col = u.pn * 256 + wc * 32 + 8 * fq; const int row0 = u.pm * BM + wr * 64 + fr;
        f32x4 gv[2][2];
#pragma unroll
        for (int bj = 0; bj < 2; ++bj)
#pragma unroll
            for (int n = 0; n < 2; ++n) gv[bj][n] = *(const f32x4*)(gate + (size_t)modrow * 6144 + col + bj * HALF + 4 * n) * gscale;
        f32x4 cur[2][2], nxt[2][2];
#pragma unroll
        for (int bj = 0; bj < 2; ++bj)
#pragma unroll
            for (int n = 0; n < 2; ++n) cur[bj][n] = *(const f32x4*)(inb + (size_t)row0 * 1024 + col + bj * HALF + 4 * n);
#pragma unroll
        for (int it = 0; it < 8; ++it) { const int ai = it >> 2, m = it & 3; const size_t off = (size_t)(row0 + ai * HALF + m * 16) * 1024 + col;
            if (it < 7) { const size_t offn = (size_t)(row0 + ((it + 1) >> 2) * HALF + ((it + 1) & 3) * 16) * 1024 + col;
#pragma unroll
                for (int bj = 0; bj < 2; ++bj)
#pragma unroll
                    for (int n = 0; n < 2; ++n) nxt[bj][n] = *(const f32x4*)(inb + offn + bj * HALF + 4 * n); }
#pragma unroll
            for (int bj = 0; bj < 2; ++bj)
#pragma unroll
                for (int n = 0; n < 2; ++n) { *(f32x4*)(outb + off + bj * HALF + 4 * n) = cur[bj][n] + gv[bj][n] * acc[ai][bj][m][n]; cur[bj][n] = nxt[bj][n]; }
            asm volatile("" ::: "memory"); }
    }
};
struct EpiPart {
    static constexpr bool PERM = false, AFTER_DRAIN = false;
    float* P;
    __device__ __forceinline__ void operator()(const f32x4 (&acc)[2][2][4][2], const Unit& u, int wr, int wc, int fr, int fq) const {
        const int col = u.pn * 256 + wc * 32 + 8 * fq; const int row0 = u.pm * BM + wr * 64 + fr;
#pragma unroll
        for (int ai = 0; ai < 2; ++ai)
#pragma unroll
            for (int m = 0; m < 4; ++m) { float* rp = P + (size_t)(row0 + ai * HALF + m * 16) * 1024 + col;
#pragma unroll
                for (int bj = 0; bj < 2; ++bj)
#pragma unroll
                    for (int n = 0; n < 2; ++n) *(f32x4*)(rp + bj * HALF + 4 * n) = acc[ai][bj][m][n]; }
    }
};
struct EpiGU {
    static constexpr bool PERM = false, AFTER_DRAIN = false;
    bf16_t* ACT;
    __device__ __forceinline__ void operator()(const f32x4 (&acc)[2][2][4][2], const Unit& u, int wr, int wc, int fr, int fq) const {
        const int row0 = u.pm * BM + wr * 64 + fr;
#pragma unroll
        for (int ai = 0; ai < 2; ++ai)
#pragma unroll
            for (int m = 0; m < 4; ++m) { bf16_t* rowp = ACT + (size_t)(row0 + ai * HALF + m * 16) * DFF + u.pn * 128 + wc * 32 + 8 * fq;
                float r[8];
#pragma unroll
                for (int n = 0; n < 2; ++n)
#pragma unroll
                    for (int e = 0; e < 4; ++e) { const float g = acc[ai][0][m][n][e], up = acc[ai][1][m][n][e]; r[4 * n + e] = g * sigmoidf_(g) * up; }
                u32x4 w; w.x = pk2(r[0], r[1]); w.y = pk2(r[2], r[3]); w.z = pk2(r[4], r[5]); w.w = pk2(r[6], r[7]);
                *(u32x4*)rowp = w; }
    }
};
struct EpiFM {
    static constexpr bool PERM = true, AFTER_DRAIN = false;
    bf16_t* FM; int rowbase0, rpb;
    __device__ __forceinline__ void operator()(const f32x4 (&acc)[2][2][4][2], const Unit& u, int wr, int wc, int fr, int fq) const {
        const int b = u.pn >> 1; const int ncol = (u.pn & 1) * 256 + wc * 32 + 8 * fq;
        const int r0 = rowbase0 + b * rpb + u.pm * BM + wr * 64 + fr;
#pragma unroll
        for (int ai = 0; ai < 2; ++ai)
#pragma unroll
            for (int m = 0; m < 4; ++m) { bf16_t* rowp = FM + (size_t)(r0 + ai * HALF + m * 16) * 512 + ncol;
#pragma unroll
                for (int bj = 0; bj < 2; ++bj) { const f32x4 v0 = acc[ai][bj][m][0], v1 = acc[ai][bj][m][1];
                    u32x4 w; w.x = pk2(v0[0], v0[1]); w.y = pk2(v0[2], v0[3]); w.z = pk2(v1[0], v1[1]); w.w = pk2(v1[2], v1[3]);
                    *(u32x4*)(rowp + bj * HALF) = w; } }
    }
};
}

#define XB_TMO      128
#define XB_XCNT(j)  (256  + 64 * (j))
#define XB_XSUB(j)  (1280 + 64 * (j))
#define XB_XGEN(j)  (2304 + 64 * (j))
#define XB_TOP      3328
#define XB_TOPGEN   3392
#define XCD_BAR_WORDS 3456
#define XB_SPIN_CAP (1u << 18)

__device__ __forceinline__ unsigned xb_ld(unsigned* p)              { return __hip_atomic_load(p, __ATOMIC_RELAXED, __HIP_MEMORY_SCOPE_AGENT); }
__device__ __forceinline__ unsigned xb_add(unsigned* p, unsigned v) { return __hip_atomic_fetch_add(p, v, __ATOMIC_RELAXED, __HIP_MEMORY_SCOPE_AGENT); }
__device__ __forceinline__ unsigned xb_xcc_id() { return (unsigned)__builtin_amdgcn_s_getreg((3 << 11) | 20) & 0xFu; }
#define XB_SPIN(cond, bar) do { unsigned _sp = 0; while (cond) { __builtin_amdgcn_s_sleep(1); \
    if ((++_sp & 255u) == 0u) { if (xb_ld(&(bar)[XB_TMO])) break; if (_sp > XB_SPIN_CAP) { atomicAdd(&(bar)[XB_TMO], 1u); break; } } } } while (0)

struct XcdBarrier {
    unsigned* bar; unsigned x;
    volatile LAS unsigned* st;
};

__device__ __forceinline__ XcdBarrier xcd_barrier_post(unsigned* bar, volatile LAS unsigned* st) {
    XcdBarrier b; b.bar = bar; b.x = xb_xcc_id(); b.st = st;
    if (threadIdx.x == 0) (void)xb_add(&bar[XB_XCNT(b.x)], 1u);
    return b;
}
__device__ __forceinline__ void xcd_barrier_complete(unsigned* bar, unsigned x, unsigned& nloc, unsigned& nx) {
    const unsigned G = gridDim.x * gridDim.y * gridDim.z;
    unsigned sum, cnt, mine, sp = 0u;
    for (;;) {
        sum = 0u; cnt = 0u; mine = 0u;
#pragma unroll
        for (unsigned j = 0; j < 16; ++j) { const unsigned c = xb_ld(&bar[XB_XCNT(j)]); sum += c; cnt += (c > 0u) ? 1u : 0u; mine = (j == x) ? c : mine; }
        if (sum == G) break;
        __builtin_amdgcn_s_sleep(1);
        if ((++sp & 255u) == 0u) { if (xb_ld(&bar[XB_TMO])) break; if (sp > XB_SPIN_CAP) { atomicAdd(&bar[XB_TMO], 1u); break; } }
    }
    nloc = mine > 0u ? mine : 1u; nx = cnt > 0u ? cnt : 1u;
}

__device__ __forceinline__ void xcd_barrier(const XcdBarrier& b) {
    asm volatile("s_waitcnt vmcnt(0)" ::: "memory");
    __syncthreads();
    if (threadIdx.x == 0) {
        unsigned* bar = b.bar;
        __builtin_amdgcn_s_waitcnt(0);
        unsigned nloc = b.st[0], nx = b.st[1];
        if (nloc == 0u) { xcd_barrier_complete(bar, b.x, nloc, nx); b.st[0] = nloc; b.st[1] = nx; }
        const unsigned old = xb_add(&bar[XB_XSUB(b.x)], 1u);
        const unsigned gen = old / nloc;
        if (old + 1u == (gen + 1u) * nloc) {
            __builtin_amdgcn_fence(__ATOMIC_RELEASE, "agent");
            asm volatile("s_waitcnt vmcnt(0)" ::: "memory");
            const unsigned og = xb_add(&bar[XB_TOP], 1u);
            const unsigned tg = og / nx;
            if (og + 1u == (tg + 1u) * nx) xb_add(&bar[XB_TOPGEN], 1u);
            else XB_SPIN(xb_ld(&bar[XB_TOPGEN]) == tg, bar);
            __builtin_amdgcn_fence(__ATOMIC_ACQUIRE, "agent");
            xb_add(&bar[XB_XGEN(b.x)], 1u);
            asm volatile("s_waitcnt vmcnt(0)" ::: "memory");
        } else {
            XB_SPIN(xb_ld(&bar[XB_XGEN(b.x)]) == gen, bar);
            __builtin_amdgcn_fence(__ATOMIC_ACQUIRE, "agent");
            asm volatile("s_waitcnt vmcnt(0)" ::: "memory");
        }
    }
    __syncthreads();
}

namespace att {
using bf16x8 = __attribute__((ext_vector_type(8))) short;
using s16x4 = __attribute__((ext_vector_type(4))) short;
using f32x16 = __attribute__((ext_vector_type(16))) float;
constexpr int SHM_V = 16384, SHM_K = 16384;
constexpr int SLOT = SHM_K + SHM_V, NSLOT = 4, OFF_LI = NSLOT * SLOT, ATT_LDS = OFF_LI + 2048;
#define KSWZ(row, colB) ((row) * 256 + ((colB) ^ (((row) & 7) << 4)))
#define SBAR() __builtin_amdgcn_sched_barrier(0)
__device__ __forceinline__ int crow(int r, int hi) { return (r & 3) + 8 * (r >> 2) + 4 * hi; }
__device__ __forceinline__ unsigned cvtpk(float lo, float hi) { return pk2(lo, hi); }
__device__ __forceinline__ int v_st(int k, int c) { const int kk = (k & ~0xC) | ((k & 4) << 1) | ((k & 8) >> 1); return ((kk >> 3) * 4 + (c >> 5)) * 512 + ((kk & 7) * 32 + (c & 31)) * 2; }
__device__ __forceinline__ int v_rd_base(int lane) { return ((lane & 3) << 3) | (((lane >> 2) & 3) << 6) | (((lane >> 4) & 1) << 5) | (((lane >> 5) & 1) << 8); }
constexpr int v_rd_off(int d0, int ks, int half) { return d0 * 512 + ks * 4096 + half * 2048; }
template <int OFF> __device__ __forceinline__ s16x4 tr_read(int vb) { s16x4 r; asm volatile("ds_read_b64_tr_b16 %0, %1 offset:%2" : "=&v"(r) : "v"(vb), "i"(OFF) : "memory"); return r; }
template <int D0> __device__ __forceinline__ void pv_one(f32x16& od, int vb, const bf16x8* pa) {
    const s16x4 l0 = tr_read<v_rd_off(D0, 0, 0)>(vb), h0 = tr_read<v_rd_off(D0, 0, 1)>(vb), l1 = tr_read<v_rd_off(D0, 1, 0)>(vb), h1 = tr_read<v_rd_off(D0, 1, 1)>(vb);
    const s16x4 l2 = tr_read<v_rd_off(D0, 2, 0)>(vb), h2 = tr_read<v_rd_off(D0, 2, 1)>(vb), l3 = tr_read<v_rd_off(D0, 3, 0)>(vb), h3 = tr_read<v_rd_off(D0, 3, 1)>(vb);
    asm volatile("s_waitcnt lgkmcnt(0)" ::: "memory"); SBAR();
#define PK(L, H) (bf16x8){L[0], L[1], L[2], L[3], H[0], H[1], H[2], H[3]}
    od = __builtin_amdgcn_mfma_f32_32x32x16_bf16(pa[0], PK(l0, h0), od, 0, 0, 0);
    od = __builtin_amdgcn_mfma_f32_32x32x16_bf16(pa[1], PK(l1, h1), od, 0, 0, 0);
    od = __builtin_amdgcn_mfma_f32_32x32x16_bf16(pa[2], PK(l2, h2), od, 0, 0, 0);
    od = __builtin_amdgcn_mfma_f32_32x32x16_bf16(pa[3], PK(l3, h3), od, 0, 0, 0);
#undef PK
}
__device__ __forceinline__ void smx(f32x16& p0, f32x16& p1, float& l_acc, bf16x8* pa) {
#pragma unroll
    for (int r = 0; r < 16; ++r) { p0[r] = __builtin_amdgcn_exp2f(p0[r]); p1[r] = __builtin_amdgcn_exp2f(p1[r]); }
    float ps = 0.f;
#pragma unroll
    for (int r = 0; r < 16; ++r) ps += p0[r] + p1[r];
    l_acc += ps;
#define PK4(P, BASE, OUT) do { unsigned a0 = cvtpk(P[BASE + 0], P[BASE + 1]), a1 = cvtpk(P[BASE + 2], P[BASE + 3]);   \
    unsigned b0 = cvtpk(P[BASE + 4], P[BASE + 5]), b1 = cvtpk(P[BASE + 6], P[BASE + 7]);                              \
    auto r0 = __builtin_amdgcn_permlane32_swap(a0, b0, false, false); auto r1 = __builtin_amdgcn_permlane32_swap(a1, b1, false, false); \
    u32x4 w = {r0[0], r1[0], r0[1], r1[1]}; OUT = *reinterpret_cast<bf16x8*>(&w); } while (0)
    PK4(p0, 0, pa[0]); PK4(p0, 8, pa[1]); PK4(p1, 0, pa[2]); PK4(p1, 8, pa[3]);
#undef PK4
}
template <int Q> __device__ __forceinline__ void smxq(f32x16& p0, f32x16& p1, float& l_acc, bf16x8& out) {
    f32x16& P = (Q < 2) ? p0 : p1; constexpr int B = (Q & 1) * 8;
#pragma unroll
    for (int r = 0; r < 8; ++r) P[B + r] = __builtin_amdgcn_exp2f(P[B + r]);
    l_acc += ((P[B + 0] + P[B + 1]) + (P[B + 2] + P[B + 3])) + ((P[B + 4] + P[B + 5]) + (P[B + 6] + P[B + 7]));
    const unsigned a0 = cvtpk(P[B + 0], P[B + 1]), a1 = cvtpk(P[B + 2], P[B + 3]), b0 = cvtpk(P[B + 4], P[B + 5]), b1 = cvtpk(P[B + 6], P[B + 7]);
    auto r0 = __builtin_amdgcn_permlane32_swap(a0, b0, false, false); auto r1 = __builtin_amdgcn_permlane32_swap(a1, b1, false, false);
    u32x4 w = {r0[0], r1[0], r0[1], r1[1]}; out = *reinterpret_cast<bf16x8*>(&w);
}
template <bool DRY> __device__ __forceinline__ void attn_unit(const bf16_t* Qw_, const bf16_t* Kc, const bf16_t* Vc, const bf16_t* Kl, const bf16_t* Vl, int NT,
                                          bf16_t* Ow_, float lam, float negM, const float* subg, float oscale, char* lds, const int wave_s_) {
    const int tid = threadIdx.x, wid = __builtin_amdgcn_readfirstlane(tid >> 6), lane = tid & 63, r32 = lane & 31, hi = lane >> 5, rg = wid & 3, br = wid >> 2;
    float* li = (float*)(lds + OFF_LI) + wid * 64;
    float l_acc = 0.f; f32x16 o[4]; bf16x8 qr[4];
#pragma unroll
    for (int d = 0; d < 4; ++d)
#pragma unroll
        for (int r = 0; r < 16; ++r) o[d][r] = 0.f;
    { const bf16_t* Qw = Qw_ + (size_t)(rg * 32 + r32) * 1024 + br * 64 + hi * 8;
#pragma unroll
      for (int d0 = 0; d0 < 4; ++d0) qr[d0] = *reinterpret_cast<const bf16x8*>(Qw + d0 * 16); }
    int kofs[2], vofs[2];
#pragma unroll
    for (int i = 0; i < 2; ++i) { const int c = 2 * wid + i;
        { const int row = 4 * c + (lane >> 4), colB = ((lane & 15) * 16) ^ ((row & 7) << 4); kofs[i] = row * 1024 + (colB >> 1); }
        { const int sub = 2 * c + (lane >> 5), kk = (sub >> 2) * 8 + ((lane & 31) >> 2), k = (kk & ~0xC) | ((kk & 4) << 1) | ((kk & 8) >> 1), col = (sub & 3) * 32 + (lane & 3) * 8; vofs[i] = k * 1024 + col; } }
    typedef __attribute__((address_space(3))) unsigned las_u32;
    las_u32* ring = (las_u32*)(__attribute__((address_space(3))) char*)lds;
#define DMA_TILE(j, slot) do { const bf16_t* kb_ = ((j) < 4) ? Kc + (size_t)(j) * 65536 : Kl + (size_t)((j) - 4) * 65536; \
    const bf16_t* vb_ = ((j) < 4) ? Vc + (size_t)(j) * 65536 : Vl + (size_t)((j) - 4) * 65536; \
    __builtin_amdgcn_global_load_lds((const unsigned*)(kb_ + kofs[0]), ring + ((slot) * SLOT + (2 * wid) * 1024) / 4, 16, 0, 0); \
    __builtin_amdgcn_global_load_lds((const unsigned*)(kb_ + kofs[1]), ring + ((slot) * SLOT + (2 * wid + 1) * 1024) / 4, 16, 0, 0); \
    __builtin_amdgcn_global_load_lds((const unsigned*)(vb_ + vofs[0]), ring + ((slot) * SLOT + SHM_K + (2 * wid) * 1024) / 4, 16, 0, 0); \
    __builtin_amdgcn_global_load_lds((const unsigned*)(vb_ + vofs[1]), ring + ((slot) * SLOT + SHM_K + (2 * wid + 1) * 1024) / 4, 16, 0, 0); } while (0)
    const int vb0 = (int)(uintptr_t)lds + SHM_K + v_rd_base(lane);
    DMA_TILE(0, 0); DMA_TILE(1, 1);
    asm volatile("s_waitcnt vmcnt(4) lgkmcnt(0)\n\ts_barrier" ::: "memory");
#define QK_TILE(Kt_) do { \
        _Pragma("unroll") for (int r = 0; r < 16; ++r) { p0[r] = negM; p1[r] = negM; } \
        _Pragma("unroll") for (int d0 = 0; d0 < 4; ++d0) { const int cb = (br * 64 + d0 * 16 + hi * 8) * 2; \
            const bf16x8 b0 = *reinterpret_cast<const bf16x8*>((Kt_) + KSWZ(r32, cb)); \
            const bf16x8 b1 = *reinterpret_cast<const bf16x8*>((Kt_) + KSWZ(32 + r32, cb)); \
            p0 = __builtin_amdgcn_mfma_f32_32x32x16_bf16(b0, qr[d0], p0, 0, 0, 0); \
            p1 = __builtin_amdgcn_mfma_f32_32x32x16_bf16(b1, qr[d0], p1, 0, 0, 0); } } while (0)
    bf16x8 pa[4];
    { f32x16 p0, p1; QK_TILE(lds); smx(p0, p1, l_acc, pa); }
    DMA_TILE(2, 2);
    asm volatile("s_waitcnt vmcnt(4) lgkmcnt(0)\n\ts_barrier" ::: "memory");
    int slot = 1;
    for (int j = 1; j < NT; ++j) {
        if (j + 2 < NT) DMA_TILE(j + 2, (slot + 2) & 3);
        const char* Kt = lds + slot * SLOT; const int vbp = vb0 + ((slot + 3) & 3) * SLOT;
        f32x16 p0, p1; bf16x8 pn[4];
        QK_TILE(Kt);
        SBAR();
        pv_one<0>(o[0], vbp, pa); smxq<0>(p0, p1, l_acc, pn[0]); SBAR();
        pv_one<1>(o[1], vbp, pa); smxq<1>(p0, p1, l_acc, pn[1]); SBAR();
        pv_one<2>(o[2], vbp, pa); smxq<2>(p0, p1, l_acc, pn[2]); SBAR();
        pv_one<3>(o[3], vbp, pa); smxq<3>(p0, p1, l_acc, pn[3]); SBAR();
        pa[0] = pn[0]; pa[1] = pn[1]; pa[2] = pn[2]; pa[3] = pn[3];
        if (j + 2 < NT) asm volatile("s_waitcnt vmcnt(4) lgkmcnt(0)\n\ts_barrier" ::: "memory");
        else asm volatile("s_waitcnt vmcnt(0) lgkmcnt(0)\n\ts_barrier" ::: "memory");
        slot = (slot + 1) & 3;
    }
    { const int vbp = vb0 + ((slot + 3) & 3) * SLOT;
      pv_one<0>(o[0], vbp, pa); pv_one<1>(o[1], vbp, pa); pv_one<2>(o[2], vbp, pa); pv_one<3>(o[3], vbp, pa); }
#undef QK_TILE
#undef DMA_TILE
    if constexpr (DRY) { if (o[0][0] == 12345.678f) Ow_[lane] = 0; __syncthreads(); return; }
    { auto rr = __builtin_amdgcn_permlane32_swap(__float_as_uint(l_acc), __float_as_uint(l_acc), false, false); l_acc = __uint_as_float(rr[0]) + __uint_as_float(rr[1]); }
    if (hi == 0) li[r32] = l_acc;
    asm volatile("s_waitcnt lgkmcnt(0)" ::: "memory");
    float* xch = (float*)lds + (size_t)rg * 4096;
    const float lscale = br ? lam : 1.f;
#pragma unroll
    for (int r = 0; r < 16; ++r) { const float a = lscale * __builtin_amdgcn_rcpf(li[crow(r, hi)]);
#pragma unroll
        for (int d = 0; d < 4; ++d) o[d][r] *= a; }
    if (br == 1) {
#pragma unroll
        for (int r = 0; r < 16; ++r)
#pragma unroll
            for (int d = 0; d < 4; ++d) xch[(r * 4 + d) * 64 + lane] = o[d][r];
    }
    __syncthreads();
    if (br == 0) {
        float ss[16];
#pragma unroll
        for (int r = 0; r < 16; ++r) { float s = 0.f;
#pragma unroll
            for (int d = 0; d < 4; ++d) { const float v = o[d][r] - xch[(r * 4 + d) * 64 + lane]; o[d][r] = v; s += v * v; }
            ss[r] = s; }
#pragma unroll
        for (int off = 1; off < 32; off <<= 1)
#pragma unroll
            for (int r = 0; r < 16; ++r) ss[r] += __shfl_xor(ss[r], off);
        float sg[4];
#pragma unroll
        for (int d = 0; d < 4; ++d) sg[d] = subg[d * 32 + r32] * oscale;
        bf16_t* stg = (bf16_t*)(lds + 65536 + rg * 8192);
#pragma unroll
        for (int r = 0; r < 16; ++r) { const float rn = rsqrtf(ss[r] * (1.f / 128.f) + EPS); const int orow = crow(r, hi);
#pragma unroll
            for (int d = 0; d < 4; ++d) stg[orow * 128 + d * 32 + r32] = (bf16_t)f2bf(o[d][r] * rn * sg[d]); }
        asm volatile("s_waitcnt lgkmcnt(0)" ::: "memory");
        bf16_t* Ow = Ow_ + (size_t)(rg * 32) * 1024;
#pragma unroll
        for (int i = 0; i < 8; ++i) { const int row = i * 4 + (lane >> 4), ch = lane & 15;
            const u32x4 v = *(const u32x4*)(stg + row * 128 + ch * 8);
            *(u32x4*)(Ow + (size_t)row * 1024 + ch * 8) = v; }
    }
    __syncthreads();
}
#undef SBAR
}

__device__ __forceinline__ int colmap(int id, int rho) {
    const int local = rho & 255, hi_ = rho & ~255;
    const int s8 = (rho & ~31) | (((rho >> 2) & 3) << 3) | (((rho >> 4) & 1) << 2) | (rho & 3);
    if (id == 2) return s8;
    if (id == 1) return 3584 + s8;
    if (id == 0) { if ((rho >> 10) == 1) return s8; const int bj = local >> 7, wc = (local >> 5) & 3, rest = local & 31; return hi_ + 64 * wc + 32 * bj + rest; }
    { const int pn = rho >> 8, bj = local >> 7; return bj * DFF + 128 * pn + (s8 & 127); }
}
__device__ __forceinline__ void tr_item(const float* W, int K, int N, bf16_t* WT, int nrb, int id, LAS float* scr, int item, int lane) {
    const int kb = item / nrb, rb = item % nrb, k0 = 64 * kb, r0 = 32 * rb;
    const int c = colmap(id, r0 + (lane & 31));
    float wv[32];
#pragma unroll
    for (int i = 0; i < 32; ++i) wv[i] = W[(size_t)(k0 + 2 * i + (lane >> 5)) * N + c];
#pragma unroll
    for (int i = 0; i < 32; ++i) scr[(2 * i + (lane >> 5)) * 33 + (lane & 31)] = wv[i];
    asm volatile("s_waitcnt lgkmcnt(0)" ::: "memory");
    const int ch = lane & 7;
#pragma unroll
    for (int j = 0; j < 4; ++j) { const int n = (lane >> 3) + 8 * j; const LAS float* s = scr + (8 * ch) * 33 + n;
        u32x4 o; o.x = pk2(s[0 * 33], s[1 * 33]); o.y = pk2(s[2 * 33], s[3 * 33]); o.z = pk2(s[4 * 33], s[5 * 33]); o.w = pk2(s[6 * 33], s[7 * 33]);
        *(u32x4*)(WT + (size_t)(r0 + n) * K + k0 + 8 * ch) = o; }
    asm volatile("s_waitcnt lgkmcnt(0)" ::: "memory");
}

struct Args { const float* in[21]; float* out; unsigned char* ws; int ph_lo, ph_hi; };
enum { I_X = 0, I_C, I_CTX, I_CCTX, I_WADA, I_BADA, I_N1G, I_N2G, I_WIN, I_QNG, I_KNG, I_LQ1, I_LK1, I_LQ2, I_LK2, I_SUBG, I_WPA, I_WPF, I_WOUT, I_WGU, I_WD };
constexpr int N_PHASES = 19;
#ifndef ONLY_S
#define ONLY_S -1
#endif
constexpr int only_s = ONLY_S;
#define PS(n) ((only_s < 0 || only_s == (n)) && s == (n))

__device__ __forceinline__ void norm_rows(const float* lat, const float* ctx, const float* g, const float* mod, int shidx, int scidx, bf16_t* H, int M, int gw, int NGW, int lane, const float* PP = nullptr, const float* pgate = nullptr, float* wb = nullptr) {
    for (int row = gw; row < M; row += NGW) {
        const float* src = row < M_LAT ? lat + (size_t)row * 1024 : ctx + (size_t)(row - M_LAT) * 1024;
        const int modrow = row < M_LAT ? (row >> 11) : 16;
        const f32x4* xr = (const f32x4*)src + lane;
        f32x4 v[4]; float ss = 0.f;
#pragma unroll
        for (int j = 0; j < 4; ++j) { v[j] = xr[64 * j];
            if (PP && row >= M_LAT) { const f32x4* pa = (const f32x4*)(PP + (size_t)(row - M_LAT) * 1024) + lane; const f32x4* pb = pa + (size_t)M_CTX * 256;
                v[j] += *((const f32x4*)pgate + lane + 64 * j) * (pa[64 * j] + pb[64 * j]);
                if (wb) ((f32x4*)(wb + (size_t)(row - M_LAT) * 1024) + lane)[64 * j] = v[j]; }
            ss += (v[j].x * v[j].x + v[j].y * v[j].y) + (v[j].z * v[j].z + v[j].w * v[j].w); }
        const float rinv = rsqrtf(wave_sum(ss) * (1.f / 1024.f) + EPS);
        const float* mr = mod + (size_t)modrow * 6144;
        u32x2* o8 = (u32x2*)(H + (size_t)row * 1024) + lane;
#pragma unroll
        for (int j = 0; j < 4; ++j) { const int col = 4 * (lane + 64 * j);
            const f32x4 gg = *(const f32x4*)(g + col), sc = *(const f32x4*)(mr + scidx * 1024 + col), sh = *(const f32x4*)(mr + shidx * 1024 + col);
            const f32x4 h = v[j] * rinv * gg * (sc + 1.f) + sh;
            u32x2 w; w.x = pk2(h.x, h.y); w.y = pk2(h.z, h.w); o8[64 * j] = w; }
    }
}

#ifndef MK_XBAR
#define MK_XBAR 1
#endif
#ifndef MK_SP2
#define MK_SP2 false
#endif
#ifndef MK_ALIGN
#define MK_ALIGN false
#endif
#ifndef MK_ALIGN_RES
#define MK_ALIGN_RES MK_ALIGN
#endif
#ifndef MK_ALIGN_KVQ
#define MK_ALIGN_KVQ MK_ALIGN
#endif
struct Ctx { int G, bx, vcu, gw, NGW, lane, tid, wave; };

typedef const __attribute__((address_space(4))) Args* KArgP;
#define KARGS() ((KArgP)__builtin_amdgcn_kernarg_segment_ptr())
__device__ __forceinline__ void p0_phase(LAS unsigned char* lds3, const Ctx& c) {
    KArgP ap = KARGS();
    unsigned char* ws = ap->ws; const int tid = c.tid, lane = c.lane, wave = c.wave, G = c.G, vcu = c.vcu;
    float* SM = (float*)(ws + OFF_LAM); float* ROPE = (float*)(ws + OFF_ROPE); float* MOD = (float*)(ws + OFF_MOD);
    bf16_t* DFT = (bf16_t*)(ws + WS_DFT); bf16_t* DFTC = (bf16_t*)(ws + WS_DFTC);
    LAS float* tab = (LAS float*)(lds3 + 110592);
    for (int i = tid; i < 2048; i += 512) tab[i] = cospif((float)i * (1.f / 1024.f));
    __syncthreads();
#ifndef SKIP_P0A
    { LAS float* scr = (LAS float*)(lds3 + wave * 8448);
      constexpr int PER_L = 8064;
      for (int it = c.gw; it < 2 * PER_L; it += c.NGW) {
          const int l = it / PER_L; int r = it % PER_L;
          unsigned char* wl = ws + WS_W + (size_t)l * W_LSTRIDE;
          const float* win = ap->in[I_WIN] + (size_t)l * 1024 * INW;
          if (r < 1536) { tr_item(win, 1024, INW, (bf16_t*)(wl + W_KVQ), 96, 0, scr, r, lane); continue; } r -= 1536;
          if (r < 1024) { tr_item(win, 1024, INW, (bf16_t*)(wl + W_G), 64, 1, scr, r, lane); continue; } r -= 1024;
          if (r < 512) { tr_item(ap->in[I_WPA] + (size_t)l * 1024 * 1024, 1024, 1024, (bf16_t*)(wl + W_PA), 32, 2, scr, r, lane); continue; } r -= 512;
          if (r < 256) { tr_item(ap->in[I_WPF] + (size_t)l * 512 * 1024, 512, 1024, (bf16_t*)(wl + W_PF), 32, 2, scr, r, lane); continue; } r -= 256;
          if (r < 512) { tr_item(ap->in[I_WOUT] + (size_t)l * 1024 * 1024, 1024, 1024, (bf16_t*)(wl + W_OUT), 32, 2, scr, r, lane); continue; } r -= 512;
          if (r < 2816) { tr_item(ap->in[I_WGU] + (size_t)l * 1024 * 2 * DFF, 1024, 2 * DFF, (bf16_t*)(wl + W_GU), 176, 3, scr, r, lane); continue; } r -= 2816;
          tr_item(ap->in[I_WD] + (size_t)l * DFF * 1024, DFF, 1024, (bf16_t*)(wl + W_D), 32, 2, scr, r, lane);
      } }
    __syncthreads();
#endif
#ifndef SKIP_P0B
    { LAS float* wt = (LAS float*)lds3;
      for (int it = vcu; it < 256; it += G) {
          const int l = it >> 7, g = (it >> 5) & 3, kb = it & 31, k0 = kb * 32;
          const float* win = ap->in[I_WIN] + (size_t)l * 1024 * INW + 3072 + g * 128;
          for (int i = tid; i < 32 * 128; i += 512) { const int kk = i >> 7, cc = i & 127; wt[kk * 129 + cc] = win[(size_t)(k0 + kk) * INW + cc]; }
          __syncthreads();
          bf16_t* wf = (bf16_t*)(ws + WS_W + (size_t)l * W_LSTRIDE + W_F);
          const int kk = tid & 31, cg0 = (tid >> 5) * 4;
          for (int cc = 0; cc < 4; ++cc) { const int cp = cg0 + cc; float ac = 0.f, as = 0.f, a64 = 0.f;
              for (int ci = 0; ci < 128; ++ci) { const int idx = ((ci * cp) & 127) * 16; const float w = wt[kk * 129 + ci]; ac += w * tab[idx]; as += w * tab[(idx - 512) & 2047]; a64 += (ci & 1) ? -w : w; }
              const int r = 2 * (g * 64 + cp);
              wf[(size_t)r * 1024 + k0 + kk] = (bf16_t)f2bf(ac * 0.08838834764831845f);
              wf[(size_t)(r + 1) * 1024 + k0 + kk] = (bf16_t)f2bf((cp == 0 ? a64 : as) * 0.08838834764831845f);
              if (l == 0) { bf16_t* wc_ = (bf16_t*)(ws + WS_WFC) + k0 + kk;
                  const unsigned uc = f2bf(ac * 0.08838834764831845f), us = f2bf(as * 0.08838834764831845f);
                  if (cp == 0) { wc_[(size_t)(2 * (g * 128)) * 1024] = (bf16_t)uc; wc_[(size_t)(2 * (g * 128) + 1) * 1024] = 0;
                                 wc_[(size_t)(2 * (g * 128 + 64)) * 1024] = (bf16_t)f2bf(a64 * 0.08838834764831845f); wc_[(size_t)(2 * (g * 128 + 64) + 1) * 1024] = 0; }
                  else { wc_[(size_t)(2 * (g * 128 + cp)) * 1024] = (bf16_t)uc; wc_[(size_t)(2 * (g * 128 + cp) + 1) * 1024] = (bf16_t)us;
                         wc_[(size_t)(2 * (g * 128 + 128 - cp)) * 1024] = (bf16_t)uc; wc_[(size_t)(2 * (g * 128 + 128 - cp) + 1) * 1024] = (bf16_t)(us ^ 0x8000u); } } }
          __syncthreads();
      } }
#endif
#ifndef SKIP_P0C
    { const int gt = vcu * 512 + tid, NGT = G * 512;
      for (int idx = gt; idx < 2048 * (ZK / 8); idx += NGT) { const int tp = idx / (ZK / 8), k8 = (idx % (ZK / 8)) * 8; float v[8];
#pragma unroll
          for (int e = 0; e < 8; ++e) { const int k = k8 + e; float x;
              if (k < 1024) x = tab[(k * tp) & 2047];
              else if (k < 2048) x = -tab[((((k - 1024) * tp) & 2047) - 512) & 2047];
              else if (k == 2048) x = (tp & 1) ? -1.f : 1.f;
              else x = 0.f;
              v[e] = x * 0.022097086912079608f; }
          u32x4 w; w.x = pk2(v[0], v[1]); w.y = pk2(v[2], v[3]); w.z = pk2(v[4], v[5]); w.w = pk2(v[6], v[7]);
          *(u32x4*)(DFT + (size_t)tp * ZK + k8) = w; }
      for (int idx = gt; idx < 256 * 64; idx += NGT) { const int tp = idx >> 6, k8 = (idx & 63) * 8; float v[8];
#pragma unroll
          for (int e = 0; e < 8; ++e) { const int k = k8 + e, cs = k >> 8, t = k & 255, aa = ((t * tp) & 255) * 8; v[e] = (cs ? -tab[(aa - 512) & 2047] : tab[aa]) * 0.0625f; }
          u32x4 w; w.x = pk2(v[0], v[1]); w.y = pk2(v[2], v[3]); w.z = pk2(v[4], v[5]); w.w = pk2(v[6], v[7]);
          *(u32x4*)(DFTC + (size_t)tp * 512 + k8) = w; } }
#endif
#ifndef SKIP_P0D
    if (c.bx == G - 1) {
        for (int i = tid; i < 1024; i += 512) { const int pos = i >> 4, f = i & 15; const float invf = powf(10000.f, -(float)f * (1.f / 16.f)); const float ang = (float)pos * invf;
            ROPE[i] = cosf(ang); ROPE[1024 + i] = sinf(ang); }
        if (tid < 2) { const int l = tid; float s1 = 0.f, s2 = 0.f, mq = 0.f, mk = 0.f;
            for (int i = 0; i < 64; ++i) { s1 += ap->in[I_LQ1][l * 64 + i] * ap->in[I_LK1][l * 64 + i]; s2 += ap->in[I_LQ2][l * 64 + i] * ap->in[I_LK2][l * 64 + i];
                mq = fmaxf(mq, fabsf(ap->in[I_QNG][l * 64 + i])); mk = fmaxf(mk, fabsf(ap->in[I_KNG][l * 64 + i])); }
            const float lam_init = 0.8f - 0.6f * expf(-0.3f * (float)l);
            SM[l] = expf(s1) - expf(s2) + lam_init; SM[2 + l] = -(8.f * mq * mk * LOG2E); SM[4 + l] = lam_init; }
    }
    __syncthreads();
#endif
#ifndef SKIP_P0E
    { LAS float* sl = (LAS float*)lds3;
      LAS float* part = (LAS float*)(lds3 + 69632);
      for (int i = tid; i < 17 * 1024; i += 512) { const int b = i >> 10, k = i & 1023; const float cv = b < 16 ? ap->in[I_C][b * 1024 + k] : ap->in[I_CCTX][k]; sl[i] = cv * sigmoidf_(cv); }
      __syncthreads();
      for (int it = vcu; it < 192; it += G) {
          const int l = it / 96, n0 = (it % 96) * 64;
          const float* wa = ap->in[I_WADA] + (size_t)l * 1024 * 6144 + n0 + lane;
          float acc[17];
#pragma unroll
          for (int b = 0; b < 17; ++b) acc[b] = 0.f;
#pragma unroll 4
          for (int kk = 0; kk < 128; ++kk) { const int k = wave * 128 + kk; const float w = wa[(size_t)k * 6144];
#pragma unroll
              for (int b = 0; b < 17; ++b) acc[b] += w * sl[b * 1024 + k]; }
#pragma unroll
          for (int b = 0; b < 17; ++b) part[(wave * 17 + b) * 64 + lane] = acc[b];
          __syncthreads();
          for (int i = tid; i < 17 * 64; i += 512) { const int b = i >> 6, n = i & 63; float v = ap->in[I_BADA][l * 6144 + n0 + n];
#pragma unroll
              for (int w = 0; w < 8; ++w) v += part[(w * 17 + b) * 64 + n];
              MOD[((size_t)l * 17 + b) * 6144 + n0 + n] = v; }
          __syncthreads();
      } }
#endif
}

template <int L, int S> __device__ __forceinline__ void run_phase(unsigned char* lds, const Ctx& c) {
    KArgP ap = KARGS();
    LAS unsigned char* lds3 = (LAS unsigned char*)lds;
    unsigned char* ws = ap->ws; const int G = c.G, bx = c.bx;
    float* SM = (float*)(ws + OFF_LAM); float* ROPE = (float*)(ws + OFF_ROPE); float* MOD = (float*)(ws + OFF_MOD);
    bf16_t* DFT = (bf16_t*)(ws + WS_DFT); bf16_t* DFTC = (bf16_t*)(ws + WS_DFTC);
    float* RC = (float*)(ws + WS_RC);
    bf16_t* Hb = (bf16_t*)(ws + WS_H); bf16_t* Qb = (bf16_t*)(ws + WS_Q); bf16_t* Kb = (bf16_t*)(ws + WS_K); bf16_t* Vb = (bf16_t*)(ws + WS_V);
    bf16_t* YT = (bf16_t*)(ws + WS_YT); bf16_t* YTC = (bf16_t*)(ws + WS_YTC); bf16_t* FM = (bf16_t*)(ws + WS_FM);
    bf16_t* Gb = Kb;
    bf16_t* ACT = Qb;
    bf16_t* MG = Hb;
    unsigned char* wl = ws + WS_W + (size_t)L * W_LSTRIDE;
    const float* modl = MOD + (size_t)L * 17 * 6144;
    constexpr int Mrows = (L == 0) ? M_ALL : M_LAT;
    const float* rin_lat = (L == 0) ? ap->in[I_X] : ap->out; const float* rin_ctx = (L == 0) ? ap->in[I_CTX] : RC;
    if constexpr (S == 0) {
        if constexpr (L == 1) norm_rows(rin_lat, rin_ctx, ap->in[I_N1G] + L * 1024, modl, 0, 1, Hb, M_ALL, c.gw, c.NGW, c.lane, (const float*)(ws + WS_FM), MOD + (size_t)16 * 6144 + 5 * 1024);
        else norm_rows(rin_lat, rin_ctx, ap->in[I_N1G] + L * 1024, modl, 0, 1, Hb, M_ALL, c.gw, c.NGW, c.lane);
    } else if constexpr (S == 1) {
        { LAS float* tabl = (LAS float*)(lds3 + 131072);
          for (int i = c.tid; i < 2048; i += 512) tabl[i] = ROPE[i];
          if (c.tid < 64) { tabl[2048 + c.tid] = ap->in[I_KNG][L * 64 + c.tid]; tabl[2112 + c.tid] = ap->in[I_QNG][L * 64 + c.tid]; }
          __syncthreads(); }
        { pg8::Gemm g{Hb, (const bf16_t*)(wl + W_KVQ), M_ALL, 3072, 1024}; pg8::StaticOrder St; St.init(M_ALL, 3072, G, bx);
          ep::EpiKVQ E{Kb, Vb, Qb, (const LAS float*)(lds3 + 131072)};
          pg8::gemm_phase<ep::EpiKVQ, pg8::StaticOrder, MK_ALIGN_KVQ, MK_SP2>(lds3, g, St, E, c.wave); }
        { pg8::Gemm g{(const bf16_t*)(wl + W_F), Hb, 512, M_LAT, 1024}; pg8::StaticOrder St; St.init(512, M_LAT, G, bx);
          ep::EpiYTm E{YT};
          pg8::gemm_phase<ep::EpiYTm, pg8::StaticOrder, MK_ALIGN, MK_SP2, 1>(lds3, g, St, E, c.wave); }
#ifndef NO_CTXG2
        if constexpr (L == 0) {
          pg8::Gemm g{(const bf16_t*)(ws + WS_WFC), Hb + (size_t)M_LAT * 1024, 1024, M_CTX, 1024}; pg8::StaticOrder St; St.init(1024, M_CTX, G, G - 1 - bx);
          ep::EpiYTc E{YTC};
          pg8::gemm_phase<ep::EpiYTc, pg8::StaticOrder, MK_ALIGN, MK_SP2>(lds3, g, St, E, c.wave); }
#endif
        { const bf16_t* Wf = (const bf16_t*)(wl + W_F);
          for (int it = c.gw; it < 16 * 512; it += c.NGW) { const int b = it >> 9, n = it & 511;
              const bf16_t* hrow = Hb + (size_t)(b * 2048 + 1024) * 1024 + c.lane * 16; const int gq = n >> 7, cq = n & 127, cm = cq <= 64 ? cq : 128 - cq; const bf16_t* wrow = Wf + (size_t)(cm == 64 ? 2 * (gq * 64) + 1 : 2 * (gq * 64 + cm)) * 1024 + c.lane * 16;
              const u32x4 h0 = *(const u32x4*)hrow, h1 = *(const u32x4*)(hrow + 8), w0 = *(const u32x4*)wrow, w1 = *(const u32x4*)(wrow + 8);
              float s = 0.f;
#pragma unroll
              for (int e = 0; e < 4; ++e) { s += bflo(h0[e]) * bflo(w0[e]) + bfhi(h0[e]) * bfhi(w0[e]); s += bflo(h1[e]) * bflo(w1[e]) + bfhi(h1[e]) * bfhi(w1[e]); }
              s = wave_sum(s);
              ((unsigned*)(YT + ((size_t)(b * 512 + n)) * ZK + 2048))[c.lane] = (c.lane == 0) ? f2bf(s) : 0u; } }
    } else if constexpr (S == 2) {
#ifndef SKIP_ATT
        const float lam = SM[L], negM = SM[2 + L], lam_init = SM[4 + L];
        constexpr int nunits = 2048 + (L == 0 ? 256 : 0);
        for (int u = c.vcu; u < nunits; u += G) {
            int b, h, qrow0, NT;
            if (u < 2048) { const int bh = u >> 4, qb = u & 15; b = bh >> 3; h = bh & 7; qrow0 = b * SEQ + qb * 128; NT = 36; }
            else { const int uc = u - 2048, bh = uc >> 1; b = bh >> 3; h = bh & 7; qrow0 = M_LAT + b * CTXL + (uc & 1) * 128; NT = 4; }
            const size_t crow0 = (size_t)(M_LAT + b * CTXL) * 1024 + h * 128, lrow0 = (size_t)(b * SEQ) * 1024 + h * 128;
#ifdef DBL_ATT
            att::attn_unit<true>(Qb + (size_t)qrow0 * 1024 + h * 128, Kb + crow0, Vb + crow0, Kb + lrow0, Vb + lrow0, NT,
                           Qb + (size_t)qrow0 * 1024 + h * 128, lam, negM, ap->in[I_SUBG] + L * 128, 1.f - lam_init, (char*)lds, c.wave);
#endif
            att::attn_unit<false>(Qb + (size_t)qrow0 * 1024 + h * 128, Kb + crow0, Vb + crow0, Kb + lrow0, Vb + lrow0, NT,
                           Qb + (size_t)qrow0 * 1024 + h * 128, lam, negM, ap->in[I_SUBG] + L * 128, 1.f - lam_init, (char*)lds, c.wave);
        }
        __syncthreads();
#endif
        { pg8::Gemm g{DFT, YT, 2048, 8192, ZK}; pg8::StaticOrder St; St.init(2048, 8192, G, bx);
          ep::EpiFM E{FM, 0, SEQ};
          pg8::gemm_phase<ep::EpiFM, pg8::StaticOrder, MK_ALIGN, MK_SP2>(lds3, g, St, E, c.wave);
#ifdef DBL_FM
          pg8::gemm_phase<ep::EpiFM, pg8::StaticOrder, MK_ALIGN, MK_SP2>(lds3, g, St, E, c.wave);
#endif
        }
        if constexpr (L == 0) { pg8::Gemm g{DFTC, YTC, 256, 8192, 512}; pg8::StaticOrder St; St.init(256, 8192, G, bx);
          ep::EpiFM E{FM, M_LAT, CTXL};
          pg8::gemm_phase<ep::EpiFM, pg8::StaticOrder, MK_ALIGN, MK_SP2>(lds3, g, St, E, c.wave); }
    } else if constexpr (S == 3) {
        pg8::Gemm g{Hb, (const bf16_t*)(wl + W_G), Mrows, 2048, 1024}; pg8::StaticOrder St; St.init(Mrows, 2048, G, bx);
        ep::EpiGate E{Gb};
        pg8::gemm_phase<ep::EpiGate, pg8::StaticOrder, MK_ALIGN, MK_SP2>(lds3, g, St, E, c.wave);
    } else if constexpr (S == 4) {
        { pg8::Gemm g{Qb, (const bf16_t*)(wl + W_PA), Mrows, 1024, 1024}; pg8::StaticOrder St; St.init(Mrows, 1024, G, bx);
          ep::EpiMerge<false> E{MG, Gb, 0};
          pg8::gemm_phase<ep::EpiMerge<false>, pg8::StaticOrder, MK_ALIGN, MK_SP2>(lds3, g, St, E, c.wave); }
        { pg8::Gemm g{FM, (const bf16_t*)(wl + W_PF), Mrows, 1024, 512}; pg8::StaticOrder St; St.init(Mrows, 1024, G, bx);
          ep::EpiMerge<true> E{MG, Gb, 1024};
          pg8::gemm_phase<ep::EpiMerge<true>, pg8::StaticOrder, MK_ALIGN, MK_SP2>(lds3, g, St, E, c.wave); }
    } else if constexpr (S == 5) {
        { pg8::Gemm g{MG, (const bf16_t*)(wl + W_OUT), M_LAT, 1024, 1024}; pg8::StaticOrder St; St.init(M_LAT, 1024, G, bx);
          ep::EpiRes E{rin_lat, rin_ctx, ap->out, RC, modl + 2 * 1024, 1.f};
          pg8::gemm_phase<ep::EpiRes, pg8::StaticOrder, MK_ALIGN_RES, MK_SP2>(lds3, g, St, E, c.wave); }
        if constexpr (L == 0) {
            float* PP = (float*)(ws + WS_FM);
            { pg8::Gemm g{MG + (size_t)M_LAT * 1024, (const bf16_t*)(wl + W_OUT), M_CTX, 1024, 512, 1024}; pg8::StaticOrder St; St.init(M_CTX, 1024, G, G - 1 - bx);
              ep::EpiPart E{PP};
              pg8::gemm_phase<ep::EpiPart, pg8::StaticOrder, MK_ALIGN, MK_SP2>(lds3, g, St, E, c.wave); }
            { pg8::Gemm g{MG + (size_t)M_LAT * 1024 + 512, (const bf16_t*)(wl + W_OUT) + 512, M_CTX, 1024, 512, 1024}; pg8::StaticOrder St; St.init(M_CTX, 1024, G, (bx + 128) % G);
              ep::EpiPart E{PP + (size_t)M_CTX * 1024};
              pg8::gemm_phase<ep::EpiPart, pg8::StaticOrder, MK_ALIGN, MK_SP2>(lds3, g, St, E, c.wave); }
        }
    } else if constexpr (S == 6) {
        if constexpr (L == 0) norm_rows(ap->out, ap->in[I_CTX], ap->in[I_N2G] + L * 1024, modl, 3, 4, Hb, Mrows, c.gw, c.NGW, c.lane, (const float*)(ws + WS_FM), modl + (size_t)16 * 6144 + 2 * 1024, RC);
        else norm_rows(ap->out, RC, ap->in[I_N2G] + L * 1024, modl, 3, 4, Hb, Mrows, c.gw, c.NGW, c.lane);
    } else if constexpr (S == 7) {
        pg8::Gemm g{Hb, (const bf16_t*)(wl + W_GU), Mrows, 2 * DFF, 1024}; pg8::StaticOrder St; St.init(Mrows, 2 * DFF, G, bx);
        ep::EpiGU E{ACT};
        pg8::gemm_phase<ep::EpiGU, pg8::StaticOrder, MK_ALIGN, MK_SP2>(lds3, g, St, E, c.wave);
    } else {
        { pg8::Gemm g{ACT, (const bf16_t*)(wl + W_D), M_LAT, 1024, DFF}; pg8::StaticOrder St; St.init(M_LAT, 1024, G, bx);
          ep::EpiRes E{ap->out, RC, ap->out, RC, modl + 5 * 1024, 1.f};
          pg8::gemm_phase<ep::EpiRes, pg8::StaticOrder, MK_ALIGN_RES, MK_SP2>(lds3, g, St, E, c.wave); }
        if constexpr (L == 0) {
            float* PP = (float*)(ws + WS_FM);
            { pg8::Gemm g{ACT + (size_t)M_LAT * DFF, (const bf16_t*)(wl + W_D), M_CTX, 1024, DFF / 2, DFF}; pg8::StaticOrder St; St.init(M_CTX, 1024, G, G - 1 - bx);
              ep::EpiPart E{PP};
              pg8::gemm_phase<ep::EpiPart, pg8::StaticOrder, MK_ALIGN, MK_SP2>(lds3, g, St, E, c.wave); }
            { pg8::Gemm g{ACT + (size_t)M_LAT * DFF + DFF / 2, (const bf16_t*)(wl + W_D) + DFF / 2, M_CTX, 1024, DFF / 2, DFF}; pg8::StaticOrder St; St.init(M_CTX, 1024, G, (bx + 128) % G);
              ep::EpiPart E{PP + (size_t)M_CTX * 1024};
              pg8::gemm_phase<ep::EpiPart, pg8::StaticOrder, MK_ALIGN, MK_SP2>(lds3, g, St, E, c.wave); }
        }
    }
}

#ifndef NVGPR
#define NVGPR 256
#endif
#ifndef PH_MASK
#define PH_MASK 0x7ffff
#endif
__global__ void __launch_bounds__(512, 2) __attribute__((amdgpu_num_vgpr(NVGPR))) fwd_mega(Args a) {
    extern __shared__ __attribute__((aligned(16))) unsigned char lds[];
    cg::grid_group grid = cg::this_grid();
#define MAKE_CTX() Ctx c; { int t_ = threadIdx.x; asm volatile("" : "+v"(t_)); c.tid = t_; } c.lane = c.tid & 63; c.wave = __builtin_amdgcn_readfirstlane(c.tid >> 6); \
    c.G = gridDim.x; c.bx = blockIdx.x; c.vcu = (c.G % 8 == 0) ? (c.bx % 8) * (c.G / 8) + c.bx / 8 : c.bx; c.gw = c.vcu * 8 + c.wave; c.NGW = c.G * 8;
    const int lo = a.ph_lo, hi = a.ph_hi;
    { int t0_ = threadIdx.x; asm volatile("" : "+v"(t0_)); for (int i = t0_; i < LDS_BYTES / 16; i += 512) ((LAS u32x4*)lds)[i] = (u32x4){0u, 0u, 0u, 0u}; }
    __syncthreads();
    XcdBarrier xbar = xcd_barrier_post((unsigned*)(a.ws + OFF_XBAR), (volatile LAS unsigned*)((LAS unsigned char*)lds + LDS_BYTES - 64));
#ifndef DBL_SYNC
#define DBL_SYNC 0
#endif
#ifndef DBL_MASK
#define DBL_MASK 0
#endif
#define PH(k, body) if (((PH_MASK >> (k)) & 1) && lo <= (k) && (k) < hi) { if ((k) > lo) { if ((k) == 1 || !MK_XBAR) grid.sync(); else { xcd_barrier(xbar); if (DBL_SYNC) { xcd_barrier(xbar); xcd_barrier(xbar); } } } MAKE_CTX(); body; if constexpr (((DBL_MASK >> (k)) & 1) != 0) { __syncthreads(); body; } }
    PH(0, p0_phase((LAS unsigned char*)lds, c))
    PH(1, (run_phase<0, 0>(lds, c)))  PH(2, (run_phase<0, 1>(lds, c)))  PH(3, (run_phase<0, 2>(lds, c)))
    PH(4, (run_phase<0, 3>(lds, c)))  PH(5, (run_phase<0, 4>(lds, c)))  PH(6, (run_phase<0, 5>(lds, c)))
    PH(7, (run_phase<0, 6>(lds, c)))  PH(8, (run_phase<0, 7>(lds, c)))  PH(9, (run_phase<0, 8>(lds, c)))
    PH(10, (run_phase<1, 0>(lds, c))) PH(11, (run_phase<1, 1>(lds, c))) PH(12, (run_phase<1, 2>(lds, c)))
    PH(13, (run_phase<1, 3>(lds, c))) PH(14, (run_phase<1, 4>(lds, c))) PH(15, (run_phase<1, 5>(lds, c)))
    PH(16, (run_phase<1, 6>(lds, c))) PH(17, (run_phase<1, 7>(lds, c))) PH(18, (run_phase<1, 8>(lds, c)))
#undef PH
}


#ifdef PROBE_STOP
__global__ void probe_dump(const bf16_t* A, const bf16_t* B, int bmask, int bshift, const float* F, float* out) {
    for (size_t i = (size_t)blockIdx.x * 256 + threadIdx.x; i < (size_t)M_LAT * 1024; i += (size_t)gridDim.x * 256) {
        float v = 0.f;
        if (A) v += bflo((unsigned)A[i]);
        if (B) { const size_t row = i >> 10, col = i & 1023; v += bflo((unsigned)B[(row << bshift) + (col & bmask)]); }
        if (F) v += F[i & (((size_t)1 << 22) - 1)];
        out[i] = v;
    }
}
__global__ void probe_diff(const bf16_t* A, const bf16_t* B, float* out) {
    for (size_t i = (size_t)blockIdx.x * 256 + threadIdx.x; i < (size_t)M_LAT * 1024; i += (size_t)gridDim.x * 256) out[i] = 1.0e6f * (bflo((unsigned)A[i]) - bflo((unsigned)B[i]));
}
#endif
extern "C" void kernel_launch(void* const* d_in, const int* in_sizes, int n_in, void* d_out, int out_size, void* d_ws, size_t ws_size, hipStream_t stream) {
    static int grid = 0;
    if (grid == 0) {
        if (n_in != 21 || ws_size < WS_END) fprintf(stderr, "kernel_launch: unexpected n_in %d or ws_size %zu (need %zu)\n", n_in, ws_size, (size_t)WS_END);
        int dev = 0, cus = 0, per_cu = 0;
        hipGetDevice(&dev); hipDeviceGetAttribute(&cus, hipDeviceAttributeMultiprocessorCount, dev);
        if (hipFuncSetAttribute((const void*)fwd_mega, hipFuncAttributeMaxDynamicSharedMemorySize, LDS_BYTES) != hipSuccess) fprintf(stderr, "kernel_launch: hipFuncSetAttribute failed\n");
        if (hipOccupancyMaxActiveBlocksPerMultiprocessor(&per_cu, (const void*)fwd_mega, 512, LDS_BYTES) != hipSuccess || per_cu < 1) { fprintf(stderr, "kernel_launch: occupancy query says %d\n", per_cu); per_cu = 1; }
        (void)hipGetLastError();
        grid = cus * 1;
        if (grid <= 0) grid = 256;
    }
    hipMemsetAsync(d_ws, 0, CTL_ZERO_BYTES, stream);
#ifdef DBG_POISON
    hipMemsetAsync((char*)d_ws + CTL_ZERO_BYTES, 0xAA, WS_END - CTL_ZERO_BYTES, stream);
    hipMemsetAsync(d_out, 0xAA, (size_t)M_LAT * 1024 * 4, stream);
#endif
    Args a{};
    for (int i = 0; i < 21; ++i) a.in[i] = (const float*)d_in[i];
    a.out = (float*)d_out; a.ws = (unsigned char*)d_ws;
#if MK_COOP
    a.ph_lo = 0; a.ph_hi = N_PHASES;
    void* args[] = {&a};
    hipError_t e = hipLaunchCooperativeKernel((const void*)fwd_mega, dim3(grid), dim3(512), args, LDS_BYTES, stream);
    if (e != hipSuccess) fprintf(stderr, "kernel_launch: cooperative launch failed: %s (grid %d)\n", hipGetErrorString(e), grid);
#else
#if defined(PROBE_STOP) && PROBE_STOP == 21
    for (int ph = 0; ph < 9; ++ph) { a.ph_lo = ph; a.ph_hi = ph + 1; hipLaunchKernelGGL(fwd_mega, dim3(grid), dim3(512), LDS_BYTES, stream, a); }
    hipMemcpyAsync((char*)d_ws + WS_YT, (char*)d_ws + WS_Q, (size_t)64 * MiB, hipMemcpyDeviceToDevice, stream);
    a.ph_lo = 8; a.ph_hi = 9; hipLaunchKernelGGL(fwd_mega, dim3(grid), dim3(512), LDS_BYTES, stream, a);
    hipLaunchKernelGGL(probe_diff, dim3(2048), dim3(256), 0, stream, (const bf16_t*)((char*)d_ws + WS_Q), (const bf16_t*)((char*)d_ws + WS_YT), (float*)d_out);
#elif defined(PROBE_STOP) && PROBE_STOP >= 100
    for (int ph = 0; ph < PROBE_STOP - 100; ++ph) { a.ph_lo = ph; a.ph_hi = ph + 1; hipLaunchKernelGGL(fwd_mega, dim3(grid), dim3(512), LDS_BYTES, stream, a); }
    hipMemcpyAsync((char*)d_ws + WS_YT, (char*)d_ws + (size_t)PROBE_BUF * MiB, (size_t)64 * MiB, hipMemcpyDeviceToDevice, stream);
    hipMemsetAsync(d_ws, 0, CTL_ZERO_BYTES, stream);
    for (int ph = 0; ph < PROBE_STOP - 100; ++ph) { a.ph_lo = ph; a.ph_hi = ph + 1; hipLaunchKernelGGL(fwd_mega, dim3(grid), dim3(512), LDS_BYTES, stream, a); }
    hipLaunchKernelGGL(probe_diff, dim3(2048), dim3(256), 0, stream, (const bf16_t*)((char*)d_ws + (size_t)PROBE_BUF * MiB), (const bf16_t*)((char*)d_ws + WS_YT), (float*)d_out);
#elif defined(PROBE_STOP)
    for (int ph = 0; ph < (PROBE_STOP == 20 ? 10 : PROBE_STOP); ++ph) { a.ph_lo = ph; a.ph_hi = ph + 1; hipLaunchKernelGGL(fwd_mega, dim3(grid), dim3(512), LDS_BYTES, stream, a); }
    { unsigned char* w = (unsigned char*)d_ws; const bf16_t* A = nullptr; const bf16_t* B = nullptr; const float* F = nullptr; int bmask = 1023, bshift = 10;
      if (PROBE_STOP == 1) { A = (const bf16_t*)(w + WS_W + W_F); B = (const bf16_t*)(w + WS_DFT); bmask = 1023; bshift = 12; F = (const float*)(w + OFF_MOD); }
      if (PROBE_STOP == 2) { A = (const bf16_t*)(w + WS_H); }
      if (PROBE_STOP == 3) { A = (const bf16_t*)(w + WS_K); B = (const bf16_t*)(w + WS_Q); }
      if (PROBE_STOP == 4) { A = (const bf16_t*)(w + WS_Q); B = (const bf16_t*)(w + WS_FM); bmask = 511; bshift = 9; }
      if (PROBE_STOP == 5) { A = (const bf16_t*)(w + WS_K); }
      if (PROBE_STOP == 6) { A = (const bf16_t*)(w + WS_H); }
      if (PROBE_STOP == 8) { A = (const bf16_t*)(w + WS_H); }
      if (PROBE_STOP == 9) { A = (const bf16_t*)(w + WS_Q); }
      if (PROBE_STOP == 11 || PROBE_STOP == 17) { A = (const bf16_t*)(w + WS_H); }
      if (PROBE_STOP == 20) { F = (const float*)(w + WS_RC); }
      if (PROBE_STOP == 12) { A = (const bf16_t*)(w + WS_K); B = (const bf16_t*)(w + WS_Q); }
      if (PROBE_STOP == 13) { A = (const bf16_t*)(w + WS_Q); B = (const bf16_t*)(w + WS_FM); bmask = 511; bshift = 9; }
      if (PROBE_STOP == 14) { A = (const bf16_t*)(w + WS_K); }
      if (PROBE_STOP == 15) { A = (const bf16_t*)(w + WS_H); }
      if (PROBE_STOP == 18) { A = (const bf16_t*)(w + WS_Q); }
      if (PROBE_STOP == 7 || PROBE_STOP == 10 || PROBE_STOP == 16) { }
      else hipLaunchKernelGGL(probe_dump, dim3(2048), dim3(256), 0, stream, A, B, bmask, bshift, F, (float*)d_out); }
#else
    for (int ph = 0; ph < N_PHASES; ++ph) { a.ph_lo = ph; a.ph_hi = ph + 1; hipLaunchKernelGGL(fwd_mega, dim3(grid), dim3(512), LDS_BYTES, stream, a); }
#endif
#endif
}
```

```cpp
#define MK_SP2 true
#define MK_ALIGN true
#define MK_ALIGN_RES false
#include <hip/hip_runtime.h>
#include <hip/hip_cooperative_groups.h>
#include <hip/hip_bf16.h>
#include <cstdio>
#include <cstdint>
namespace cg = cooperative_groups;
#ifndef MK_COOP
#define MK_COOP 1
#endif
__device__ __forceinline__ int mk_lane() { return (int)__builtin_amdgcn_mbcnt_hi(~0u, __builtin_amdgcn_mbcnt_lo(~0u, 0u)) & 63; }
namespace pg8 {
#define PG8_LAS __attribute__((address_space(3)))
typedef unsigned short bf16_t;
typedef short bf16x8 __attribute__((ext_vector_type(8)));
typedef float f32x4 __attribute__((ext_vector_type(4)));
typedef unsigned u32x4 __attribute__((ext_vector_type(4)));
constexpr int BM = 256, BK = 64, HALF = 128, HTB = HALF * BK * 2  , STAGE_BYTES = 8 * HTB, NXCD = 8, WGM = 8;

__host__ __device__ __forceinline__ int lds_byte(int r, int c) { const int st = (r >> 4) * 2 + (c >> 5), rr = r & 15, cc = c & 31, ob = rr * 64 + cc * 2; return st * 1024 + (ob ^ (((ob >> 9) & 1) << 5)); }
__host__ __device__ __forceinline__ void stage_rc(int b, int& R, int& C) { const int st = b / 1024, sb = b % 1024, swz = sb ^ (((sb >> 9) & 1) << 5); R = (st >> 1) * 16 + swz / 64; C = (st & 1) * 32 + (swz % 64) / 2; }
__host__ __device__ __forceinline__ int perm32(int rho) { const int n = rho >> 4, i = rho & 15; return 8 * (i >> 2) + 4 * n + (i & 3); }

struct Unit { int pm, pn; };
struct Gemm { const bf16_t* A; const bf16_t* Bt; int M, N, K; int ld; };

struct StaticOrder {
    int nM, nN, nwg, G, c;
    __host__ __device__ void init(int M, int N, int G_, int c_) { nM = M / BM; nN = N / BM; nwg = nM * nN; G = G_; c = c_; }
    __host__ __device__ bool next(int i, Unit& u) const {
        const long L = (long)i * G + c; if (L >= nwg) return false;
        int wgid = (int)L; { const int q = nwg / NXCD, r = nwg % NXCD, xcd = wgid % NXCD, off = wgid / NXCD; wgid = (xcd < r ? xcd * (q + 1) : r * (q + 1) + (xcd - r) * q) + off; }
        const int nig = WGM * nN, gid = wgid / nig, fm = gid * WGM, gsz = (nM - fm) < WGM ? (nM - fm) : WGM;
        u.pm = fm + ((wgid % nig) % gsz); u.pn = (wgid % nig) / gsz; return true;
    }
    __device__ __forceinline__ void a_ready(const Unit&) const {}
    __device__ __forceinline__ void done(const Unit&) const {}
};
__device__ __forceinline__ unsigned cvt_pk_bf16(float lo, float hi) { unsigned r; asm volatile("v_cvt_pk_bf16_f32 %0, %1, %2" : "=v"(r) : "v"(lo), "v"(hi)); return r; }
typedef float f32x2 __attribute__((ext_vector_type(2)));
template <class Epi, class Sched, bool ALIGN_EPI = false, bool SP2 = false, int BMODE = 0>
__device__ __forceinline__ void gemm_phase(PG8_LAS unsigned char* lds, const Gemm g, const Sched& S, const Epi& E, const int wave_s_) {
    int tid_ = threadIdx.x; asm volatile("" : "+v"(tid_));
    const int tid = tid_, wid = __builtin_amdgcn_readfirstlane(tid >> 6), lane = tid & 63, wr = wid >> 2, wc = wid & 3, fr = lane & 15, fq = lane >> 4;
    const int K = g.K, nt = K / BK, LD = g.ld ? g.ld : g.K;
    unsigned voffA[2], voffB[2]; int voffBh[2];
#pragma unroll
    for (int i = 0; i < 2; ++i) { int R, C; stage_rc(tid * 16 + i * 8192, R, C); const int Rb = Epi::PERM ? ((R & ~31) + perm32(R & 31)) : R;
        voffA[i] = (unsigned)(R * LD + C) * 2u; voffB[i] = (unsigned)(Rb * LD + C) * 2u; voffBh[i] = BMODE ? (C - Rb * LD) * 2 : (int)voffB[i]; }
    const size_t kstep = (size_t)(BK * 2);
    const size_t hstep = (size_t)HALF * LD * 2;
    const size_t tstep = 2 * hstep;
#define PG8_B0(pn_) (BMODE ? (const char*)g.Bt + (size_t)(((pn_) >> 3) * 2048 + ((pn_) & 7) * 128) * K * 2 : (const char*)g.Bt + (size_t)(pn_) * tstep)
#define PG8_B1(pn_, b0_) (BMODE ? (const char*)g.Bt + (size_t)(((pn_) >> 3) * 2048 + 2048 - ((pn_) & 7) * 128) * K * 2 : (b0_) + hstep)
    const unsigned ldsw = (unsigned)wid * 1024u;
    const int aoff = lds_byte(wr * 64 + fr, fq * 8), boff = lds_byte(wc * 32 + fr, fq * 8);
#define PG8_SA(b, h) (((b) * 2 + (h)) * HTB)
#define PG8_SB(b, h) ((4 + (b) * 2 + (h)) * HTB)
#define PG8_STAGE(bufoff, gbase, voff) do { _Pragma("unroll") for (int _i = 0; _i < 2; ++_i) \
        __builtin_amdgcn_global_load_lds((const unsigned*)((const char*)(gbase) + (voff)[_i]), (PG8_LAS unsigned*)(lds + (bufoff) + ldsw + _i * 8192), 16, 0, 0); } while (0)
#define PG8_LDA(dst, b, h) do { _Pragma("unroll") for (int m = 0; m < 4; ++m) _Pragma("unroll") for (int k = 0; k < 2; ++k) dst[m][k] = *(const PG8_LAS bf16x8*)(lds + PG8_SA(b, h) + aoff + m * 2048 + k * 1024); } while (0)
#define PG8_LDB(dst, b, h) do { _Pragma("unroll") for (int n = 0; n < 2; ++n) _Pragma("unroll") for (int k = 0; k < 2; ++k) dst[n][k] = *(const PG8_LAS bf16x8*)(lds + PG8_SB(b, h) + boff + n * 2048 + k * 1024); } while (0)
#define PG8_MMA(ai, bj, At, Bt) do { __builtin_amdgcn_s_setprio(1); _Pragma("unroll") for (int m = 0; m < 4; ++m) _Pragma("unroll") for (int n = 0; n < 2; ++n) _Pragma("unroll") for (int k = 0; k < 2; ++k) \
        acc[ai][bj][m][n] = __builtin_amdgcn_mfma_f32_16x16x32_bf16(Bt[n][k], At[m][k], acc[ai][bj][m][n], 0, 0, 0); __builtin_amdgcn_s_setprio(0); } while (0)
#define PG8_WAIT_V(n) asm volatile("s_waitcnt vmcnt(" #n ")" ::: "memory")
#define PG8_WAIT_L(n) asm volatile("s_waitcnt lgkmcnt(" #n ")" ::: "memory")
#define PG8_BAR __builtin_amdgcn_s_barrier()
#define PG8_SCHED __builtin_amdgcn_sched_barrier(0)
    Unit cur, nxt; int ui = 0;
    if (!S.next(0, cur)) return;
    f32x4 acc[2][2][4][2];
#pragma unroll
    for (int a = 0; a < 2; ++a)
#pragma unroll
        for (int b = 0; b < 2; ++b)
#pragma unroll
            for (int m = 0; m < 4; ++m)
#pragma unroll
                for (int n = 0; n < 2; ++n) acc[a][b][m][n] = (f32x4){0.f, 0.f, 0.f, 0.f};
    bf16x8 At[4][2], B0[2][2], B1[2][2];
    const char* cA = (const char*)g.A + (size_t)cur.pm * tstep; const char* cB = PG8_B0(cur.pn); const char* cBh = PG8_B1(cur.pn, cB);
    S.a_ready(cur);
    if constexpr (SP2) {
        PG8_STAGE(PG8_SB(0, 0), cB, voffB); PG8_STAGE(PG8_SB(0, 1), cBh, voffBh); PG8_STAGE(PG8_SA(0, 0), cA, voffA); PG8_STAGE(PG8_SA(0, 1), cA + hstep, voffA);
        if (wr == 1) PG8_BAR;
        PG8_WAIT_V(2); PG8_BAR;
        PG8_STAGE(PG8_SB(1, 0), cB + kstep, voffB); PG8_STAGE(PG8_SA(1, 0), cA + kstep, voffA); PG8_STAGE(PG8_SB(1, 1), cBh + kstep, voffBh);
        PG8_WAIT_V(6); PG8_BAR;
    } else {
        PG8_STAGE(PG8_SB(0, 0), cB, voffB); PG8_STAGE(PG8_SA(0, 0), cA, voffA); PG8_STAGE(PG8_SB(0, 1), cBh, voffBh); PG8_STAGE(PG8_SA(0, 1), cA + hstep, voffA);
        if (wr == 1) PG8_BAR;
        PG8_WAIT_V(4); PG8_BAR;
        PG8_STAGE(PG8_SB(1, 0), cB + kstep, voffB); PG8_STAGE(PG8_SA(1, 0), cA + kstep, voffA); PG8_STAGE(PG8_SB(1, 1), cBh + kstep, voffBh);
        PG8_WAIT_V(6); PG8_BAR;
    }
    for (;;) {
        const bool has_next = S.next(ui + 1, nxt);
        const char* nA = has_next ? (const char*)g.A + (size_t)nxt.pm * tstep : cA; const char* nB = has_next ? PG8_B0(nxt.pn) : cB; const char* nBh = has_next ? PG8_B1(nxt.pn, nB) : cBh;
        for (int t = 0; t < nt; t += 2) {
            const bool last = (t == nt - 2);
            const char* a1 = cA + (size_t)(t + 1) * kstep;
            const char* a2 = last ? nA : cA + (size_t)(t + 2) * kstep; const char* b2 = last ? nB : cB + (size_t)(t + 2) * kstep;
            const char* a3 = a2 + kstep; const char* b3 = b2 + kstep; const char* b2h = last ? nBh : cBh + (size_t)(t + 2) * kstep; const char* b3h = b2h + kstep;
            if (last && has_next) S.a_ready(nxt);
            if constexpr (SP2) {
            PG8_LDB(B0, 0, 0); PG8_LDB(B1, 0, 1); PG8_SCHED; PG8_LDA(At, 0, 0); PG8_STAGE(PG8_SA(1, 1), a1 + hstep, voffA);
            PG8_WAIT_V(8); PG8_WAIT_L(0); PG8_BAR; PG8_MMA(0, 0, At, B0); PG8_MMA(0, 1, At, B1); PG8_BAR; PG8_SCHED;
            PG8_LDA(At, 0, 1); PG8_STAGE(PG8_SB(0, 0), b2, voffB); PG8_STAGE(PG8_SB(0, 1), b2h, voffBh); PG8_STAGE(PG8_SA(0, 0), a2, voffA);
            PG8_WAIT_V(8); PG8_WAIT_L(0); PG8_BAR; PG8_MMA(1, 0, At, B0); PG8_MMA(1, 1, At, B1); PG8_BAR; PG8_SCHED;
            PG8_LDB(B0, 1, 0); PG8_LDB(B1, 1, 1); PG8_SCHED; PG8_LDA(At, 1, 0); PG8_STAGE(PG8_SA(0, 1), a2 + hstep, voffA);
            PG8_WAIT_V(8); PG8_WAIT_L(0); PG8_BAR; PG8_MMA(0, 0, At, B0); PG8_MMA(0, 1, At, B1); PG8_BAR; PG8_SCHED;
            PG8_LDA(At, 1, 1); PG8_STAGE(PG8_SB(1, 0), b3, voffB); PG8_STAGE(PG8_SB(1, 1), b3h, voffBh); PG8_STAGE(PG8_SA(1, 0), a3, voffA);
            PG8_WAIT_V(8); PG8_WAIT_L(0); PG8_BAR; PG8_MMA(1, 0, At, B0); PG8_MMA(1, 1, At, B1); PG8_BAR; PG8_SCHED;
            } else {
            PG8_LDB(B0, 0, 0); PG8_SCHED; PG8_LDA(At, 0, 0); PG8_STAGE(PG8_SA(1, 1), a1 + hstep, voffA);
            PG8_WAIT_L(8); PG8_BAR; PG8_WAIT_L(0); PG8_MMA(0, 0, At, B0); PG8_BAR; PG8_SCHED;
            PG8_LDB(B1, 0, 1); PG8_STAGE(PG8_SB(0, 0), b2, voffB);
            PG8_BAR; PG8_WAIT_L(0); PG8_MMA(0, 1, At, B1); PG8_BAR;
            PG8_LDA(At, 0, 1); PG8_STAGE(PG8_SA(0, 0), a2, voffA);
            PG8_BAR; PG8_WAIT_L(0); PG8_MMA(1, 0, At, B0); PG8_BAR; PG8_SCHED;
            PG8_STAGE(PG8_SB(0, 1), b2h, voffBh);
            PG8_WAIT_V(6); PG8_BAR; PG8_MMA(1, 1, At, B1); PG8_BAR;
            PG8_LDB(B0, 1, 0); PG8_SCHED; PG8_LDA(At, 1, 0); PG8_STAGE(PG8_SA(0, 1), a2 + hstep, voffA);
            PG8_WAIT_L(8); PG8_BAR; PG8_WAIT_L(0); PG8_MMA(0, 0, At, B0); PG8_BAR; PG8_SCHED;
            PG8_LDB(B1, 1, 1); PG8_STAGE(PG8_SB(1, 0), b3, voffB);
            PG8_BAR; PG8_WAIT_L(0); PG8_MMA(0, 1, At, B1); PG8_BAR;
            PG8_LDA(At, 1, 1); PG8_STAGE(PG8_SA(1, 0), a3, voffA);
            PG8_BAR; PG8_WAIT_L(0); PG8_MMA(1, 0, At, B0); PG8_BAR; PG8_SCHED;
            PG8_STAGE(PG8_SB(1, 1), b3h, voffBh);
            PG8_WAIT_V(6); PG8_BAR; PG8_MMA(1, 1, At, B1); PG8_BAR;
            }
        }
        if constexpr (ALIGN_EPI) { if (wr == 0) PG8_BAR; }
        if constexpr (!Epi::AFTER_DRAIN) { E(acc, cur, wr, wc, fr, fq); S.done(cur); }
        if (!has_next) break;
#pragma unroll
        for (int a = 0; a < 2; ++a)
#pragma unroll
            for (int b = 0; b < 2; ++b)
#pragma unroll
                for (int m = 0; m < 4; ++m)
#pragma unroll
                    for (int n = 0; n < 2; ++n) acc[a][b][m][n] = (f32x4){0.f, 0.f, 0.f, 0.f};
        cur = nxt; cA = nA; cB = nB; cBh = nBh; ++ui;
        if constexpr (ALIGN_EPI) { if (wr == 1) PG8_BAR; }
    }
    PG8_WAIT_V(0);
    if constexpr (!ALIGN_EPI) { if (wr == 0) PG8_BAR; }
    PG8_BAR;
    if constexpr (Epi::AFTER_DRAIN) { E.fused(acc, cur, wr, wc, fr, fq, lds, wid, lane); S.done(cur); }
#undef PG8_SA
#undef PG8_SB
#undef PG8_STAGE
#undef PG8_LDA
#undef PG8_LDB
#undef PG8_MMA
#undef PG8_WAIT_V
#undef PG8_WAIT_L
#undef PG8_BAR
#undef PG8_SCHED
}
}

constexpr int DM = 1024, NB = 16, SEQ = 2048, CTXL = 256;
constexpr int M_LAT = NB * SEQ, M_CTX = NB * CTXL, M_ALL = M_LAT + M_CTX;
constexpr int DFF = 2816, INW = 5632;
constexpr float EPS = 1e-6f;
constexpr float LOG2E = 1.4426950408889634f;
constexpr float QSCALE = 0.125f * LOG2E;
typedef unsigned short bf16_t;
typedef unsigned u32x4 __attribute__((ext_vector_type(4)));
typedef unsigned u32x2 __attribute__((ext_vector_type(2)));
typedef float f32x4 __attribute__((ext_vector_type(4)));
#define LAS __attribute__((address_space(3)))

constexpr size_t MiB = 1u << 20;
constexpr size_t OFF_LAM = 0, OFF_ROPE = 4096, OFF_XBAR = 16384, OFF_MOD = 65536, CTL_ZERO_BYTES = 1 * MiB;
constexpr size_t WS_W = 1 * MiB, W_LSTRIDE = 34 * MiB;
constexpr size_t W_KVQ = 0, W_G = 6 * MiB, W_F = 10 * MiB, W_PA = 12 * MiB, W_PF = 14 * MiB, W_OUT = 15 * MiB, W_GU = 17 * MiB, W_D = 28 * MiB;
constexpr size_t WS_DFT = 69 * MiB, WS_DFTC = 85 * MiB, WS_RC = 86 * MiB, WS_H = 102 * MiB, WS_Q = 174 * MiB, WS_K = 246 * MiB, WS_V = 318 * MiB;
constexpr size_t WS_YT = 390 * MiB, WS_YTC = 454 * MiB, WS_FM = 462 * MiB, WS_END = 498 * MiB;
constexpr int LDS_BYTES = 147456;
constexpr size_t WS_WFC = WS_DFT + 9 * MiB;
constexpr int ZK = 2176;

typedef float f32x2_t __attribute__((ext_vector_type(2))); typedef __bf16 bf16x2_t __attribute__((ext_vector_type(2)));
__device__ __forceinline__ unsigned pk2(float lo, float hi) { f32x2_t v = {lo, hi}; bf16x2_t b = __builtin_convertvector(v, bf16x2_t); return __builtin_bit_cast(unsigned, b); }
__device__ __forceinline__ float bflo(unsigned w) { return __uint_as_float(w << 16); }
__device__ __forceinline__ float bfhi(unsigned w) { return __uint_as_float(w & 0xffff0000u); }
__device__ __forceinline__ unsigned f2bf(float f) { unsigned u = __float_as_uint(f); return (u + 0x7fffu + ((u >> 16) & 1u)) >> 16; }
__device__ __forceinline__ float fast_exp2(float x) { return __builtin_amdgcn_exp2f(x); }
__device__ __forceinline__ float fast_rcp(float x) { return __builtin_amdgcn_rcpf(x); }
__device__ __forceinline__ float sigmoidf_(float x) { return fast_rcp(1.f + fast_exp2(-x * LOG2E)); }
__device__ __forceinline__ float wave_sum(float v) {
#pragma unroll
    for (int o = 1; o < 64; o <<= 1) v += __shfl_xor(v, o);
    return v;
}

namespace ep {
using pg8::Unit; using pg8::BM; using pg8::HALF;
struct EpiKVQ {
    static constexpr bool PERM = false, AFTER_DRAIN = false;
    bf16_t *Kb, *Vb, *Qb; const LAS float* tab;
    __device__ __forceinline__ void operator()(const f32x4 (&acc)[2][2][4][2], const Unit& u, int wr, int wc, int fr, int fq) const {
        const int sect = u.pn >> 2, pt = u.pn & 3;
        const int row0 = u.pm * BM + wr * 64 + fr;
        if (sect == 1) {
#pragma unroll
            for (int ai = 0; ai < 2; ++ai)
#pragma unroll
                for (int m = 0; m < 4; ++m) { bf16_t* rowp = Vb + (size_t)(row0 + ai * HALF + m * 16) * 1024 + pt * 256 + wc * 32 + 8 * fq;
#pragma unroll
                    for (int bj = 0; bj < 2; ++bj) { const f32x4 v0 = acc[ai][bj][m][0], v1 = acc[ai][bj][m][1];
                        u32x4 w; w.x = pk2(v0[0], v0[1]); w.y = pk2(v0[2], v0[3]); w.z = pk2(v1[0], v1[1]); w.w = pk2(v1[2], v1[3]);
                        *(u32x4*)(rowp + bj * HALF) = w; } }
        } else {
            const LAS float* g = tab + (sect == 0 ? 2048 : 2112); const LAS float* rope = tab; const float osc = sect == 0 ? 1.f : QSCALE; bf16_t* dst = sect == 0 ? Kb : Qb;
            const bool isctx = u.pm >= 128;
#pragma unroll
            for (int ai = 0; ai < 2; ++ai)
#pragma unroll
                for (int m = 0; m < 4; ++m) {
                    const int row = row0 + ai * HALF + m * 16;
                    float ss = 0.f;
#pragma unroll
                    for (int bj = 0; bj < 2; ++bj)
#pragma unroll
                        for (int n = 0; n < 2; ++n) { const f32x4 x = acc[ai][bj][m][n]; ss += (x[0] * x[0] + x[1] * x[1]) + (x[2] * x[2] + x[3] * x[3]); }
                    ss += __shfl_xor(ss, 16); ss += __shfl_xor(ss, 32);
                    const float rinv = rsqrtf(ss * (1.f / 64.f) + EPS) * osc;
                    const int t = row & 2047; const int pos0 = t >> 6, pos1 = t & 63;
                    bf16_t* p = dst + (size_t)row * 1024 + (pt * 4 + wc) * 64 + 16 * fq;
#pragma unroll
                    for (int bj = 0; bj < 2; ++bj) {
                        const f32x4 g0 = *(const LAS f32x4*)(g + 32 * bj + 4 * fq), g1 = *(const LAS f32x4*)(g + 32 * bj + 16 + 4 * fq);
                        f32x4 x1 = acc[ai][bj][m][0] * (g0 * rinv), x2 = acc[ai][bj][m][1] * (g1 * rinv);
                        asm volatile("" : "+v"(x1), "+v"(x2) :: "memory");
#ifndef NO_ROPE
                        if (!isctx) { const int pos = bj == 0 ? pos0 : pos1;
                            const f32x4 c = *(const LAS f32x4*)(rope + pos * 16 + 4 * fq), s = *(const LAS f32x4*)(rope + 1024 + pos * 16 + 4 * fq);
                            const f32x4 y1 = x1 * c - x2 * s, y2 = x2 * c + x1 * s; x1 = y1; x2 = y2; }
#endif
                        u32x4 w; w.x = pk2(x1[0], x1[1]); w.y = pk2(x1[2], x1[3]); w.z = pk2(x2[0], x2[1]); w.w = pk2(x2[2], x2[3]);
                        *(u32x4*)(p + 8 * bj) = w;
                        asm volatile("" ::: "memory");
                    }
                }
        }
    }
};
struct EpiYT {
    static constexpr bool PERM = true, AFTER_DRAIN = false;
    bf16_t *YT, *YTC;
    __device__ __forceinline__ void operator()(const f32x4 (&acc)[2][2][4][2], const Unit& u, int wr, int wc, int fr, int fq) const {
        const bool isctx = u.pn >= 128;
        bf16_t* base = isctx ? YTC + (size_t)(u.pn - 128) * 1024 * 256 : YT + (size_t)(u.pn >> 3) * 1024 * 2048 + (u.pn & 7) * 256;
        const int rs = isctx ? 256 : 2048;
        const int r0 = u.pm * BM + wr * 64 + fr;
#pragma unroll
        for (int ai = 0; ai < 2; ++ai)
#pragma unroll
            for (int m = 0; m < 4; ++m) { bf16_t* rowp = base + (size_t)(r0 + ai * HALF + m * 16) * rs + wc * 32 + 8 * fq;
#pragma unroll
                for (int bj = 0; bj < 2; ++bj) { const f32x4 v0 = acc[ai][bj][m][0], v1 = acc[ai][bj][m][1];
                    u32x4 w; w.x = pk2(v0[0], v0[1]); w.y = pk2(v0[2], v0[3]); w.z = pk2(v1[0], v1[1]); w.w = pk2(v1[2], v1[3]);
                    *(u32x4*)(rowp + bj * HALF) = w; } }
    }
};
struct EpiYTm {
    static constexpr bool PERM = true, AFTER_DRAIN = false;
    bf16_t* Z;
    __device__ __forceinline__ void operator()(const f32x4 (&acc)[2][2][4][2], const Unit& u, int wr, int wc, int fr, int fq) const {
        const int t0 = (u.pn & 7) * 128 + wc * 32 + 8 * fq, cs = fr & 1;
        const int r0 = u.pm * BM + wr * 64 + fr;
        bf16_t* zb = Z + (size_t)((u.pn >> 3) * 512) * ZK + t0;
#pragma unroll
        for (int ai = 0; ai < 2; ++ai)
#pragma unroll
            for (int m = 0; m < 4; ++m) { const int q = (r0 + ai * HALF + m * 16) >> 1, g = q >> 6, cp = q & 63;
                const bool c64 = (cp == 0) && cs;
                const bool costype = !cs || c64;
                const float sgn = costype ? 1.f : -1.f;
                f32x4 za = acc[ai][0][m][0] + acc[ai][1][m][0] * sgn, zc = acc[ai][0][m][1] + acc[ai][1][m][1] * sgn;
                if (t0 == 0 && costype) za[0] = acc[ai][0][m][0][0];
                u32x4 w; w.x = pk2(za[0], za[1]); w.y = pk2(za[2], za[3]); w.z = pk2(zc[0], zc[1]); w.w = pk2(zc[2], zc[3]);
                const int n1 = g * 128 + (cp ? cp : (c64 ? 64 : 0)), p1 = cp ? cs * 1024 : 0;
                const int n2 = cp ? g * 128 + 128 - cp : n1, p2 = cp ? p1 : 1024;
                const unsigned flip = (cp && cs) ? 0x80008000u : 0u, keep = cp ? 0xffffffffu : 0u;
                *(u32x4*)(zb + n1 * ZK + p1) = w;
                asm volatile("" ::: "memory");
                w.x = (w.x ^ flip) & keep; w.y = (w.y ^ flip) & keep; w.z = (w.z ^ flip) & keep; w.w = (w.w ^ flip) & keep;
                *(u32x4*)(zb + n2 * ZK + p2) = w;
                asm volatile("" ::: "memory"); }
    }
};
struct EpiYTc {
    static constexpr bool PERM = true, AFTER_DRAIN = false;
    bf16_t* YTC;
    __device__ __forceinline__ void operator()(const f32x4 (&acc)[2][2][4][2], const Unit& u, int wr, int wc, int fr, int fq) const {
        bf16_t* base = YTC + (size_t)u.pn * 1024 * 256;
        const int r0 = u.pm * BM + wr * 64 + fr;
#pragma unroll
        for (int ai = 0; ai < 2; ++ai)
#pragma unroll
            for (int m = 0; m < 4; ++m) { bf16_t* rowp = base + (size_t)(r0 + ai * HALF + m * 16) * 256 + wc * 32 + 8 * fq;
#pragma unroll
                for (int bj = 0; bj < 2; ++bj) { const f32x4 v0 = acc[ai][bj][m][0], v1 = acc[ai][bj][m][1];
                    u32x4 w; w.x = pk2(v0[0], v0[1]); w.y = pk2(v0[2], v0[3]); w.z = pk2(v1[0], v1[1]); w.w = pk2(v1[2], v1[3]);
                    *(u32x4*)(rowp + bj * HALF) = w; } }
    }
};
struct EpiGate {
    static constexpr bool PERM = false, AFTER_DRAIN = false;
    bf16_t* G;
    __device__ __forceinline__ void operator()(const f32x4 (&acc)[2][2][4][2], const Unit& u, int wr, int wc, int fr, int fq) const {
        const int row0 = u.pm * BM + wr * 64 + fr;
#pragma unroll
        for (int ai = 0; ai < 2; ++ai)
#pragma unroll
            for (int m = 0; m < 4; ++m) { bf16_t* rowp = G + (size_t)(row0 + ai * HALF + m * 16) * 2048 + u.pn * 256 + wc * 32 + 8 * fq;
#pragma unroll
                for (int bj = 0; bj < 2; ++bj) { const f32x4 v0 = acc[ai][bj][m][0], v1 = acc[ai][bj][m][1];
                    u32x4 w; w.x = pk2(sigmoidf_(v0[0]), sigmoidf_(v0[1])); w.y = pk2(sigmoidf_(v0[2]), sigmoidf_(v0[3]));
                    w.z = pk2(sigmoidf_(v1[0]), sigmoidf_(v1[1])); w.w = pk2(sigmoidf_(v1[2]), sigmoidf_(v1[3]));
                    *(u32x4*)(rowp + bj * HALF) = w; } }
    }
};
template <bool ADD> struct EpiMerge {
    static constexpr bool PERM = false, AFTER_DRAIN = false;
    bf16_t* MG; const bf16_t* G; int goff;
    __device__ __forceinline__ void operator()(const f32x4 (&acc)[2][2][4][2], const Unit& u, int wr, int wc, int fr, int fq) const {
        const int row0 = u.pm * BM + wr * 64 + fr; const int col = u.pn * 256 + wc * 32 + 8 * fq;
        u32x4 gc[2], gn[2], oc[2], on[2];
#pragma unroll
        for (int bj = 0; bj < 2; ++bj) { gc[bj] = *(const u32x4*)(G + (size_t)row0 * 2048 + goff + col + bj * HALF); if (ADD) oc[bj] = *(const u32x4*)(MG + (size_t)row0 * 1024 + col + bj * HALF); }
#pragma unroll
        for (int it = 0; it < 8; ++it) { const int ai = it >> 2, m = it & 3; const int row = row0 + ai * HALF + m * 16;
            if (it < 7) { const int rown = row0 + ((it + 1) >> 2) * HALF + ((it + 1) & 3) * 16;
#pragma unroll
                for (int bj = 0; bj < 2; ++bj) { gn[bj] = *(const u32x4*)(G + (size_t)rown * 2048 + goff + col + bj * HALF); if (ADD) on[bj] = *(const u32x4*)(MG + (size_t)rown * 1024 + col + bj * HALF); } }
#pragma unroll
            for (int bj = 0; bj < 2; ++bj) { const f32x4 v0 = acc[ai][bj][m][0], v1 = acc[ai][bj][m][1]; const u32x4 g = gc[bj];
                bf16_t* mp = MG + (size_t)row * 1024 + col + bj * HALF;
                float r[8] = {v0[0] * bflo(g.x), v0[1] * bfhi(g.x), v0[2] * bflo(g.y), v0[3] * bfhi(g.y), v1[0] * bflo(g.z), v1[1] * bfhi(g.z), v1[2] * bflo(g.w), v1[3] * bfhi(g.w)};
                if (ADD) { const u32x4 o = oc[bj];
                    r[0] += bflo(o.x); r[1] += bfhi(o.x); r[2] += bflo(o.y); r[3] += bfhi(o.y); r[4] += bflo(o.z); r[5] += bfhi(o.z); r[6] += bflo(o.w); r[7] += bfhi(o.w); }
                u32x4 w; w.x = pk2(r[0], r[1]); w.y = pk2(r[2], r[3]); w.z = pk2(r[4], r[5]); w.w = pk2(r[6], r[7]);
                *(u32x4*)mp = w; gc[bj] = gn[bj]; if (ADD) oc[bj] = on[bj]; }
            asm volatile("" ::: "memory"); }
    }
};
struct EpiRes {
    static constexpr bool PERM = false, AFTER_DRAIN = false;
    const float *in_lat, *in_ctx; float *out_lat, *out_ctx; const float* gate; float gscale;
    __device__ __forceinline__ void operator()(const f32x4 (&acc)[2][2][4][2], const Unit& u, int wr, int wc, int fr, int fq) const {
        const bool isctx = u.pm >= 128; const int modrow = isctx ? 16 : (u.pm >> 3);
        const float* inb = isctx ? in_ctx - (size_t)M_LAT * 1024 : in_lat; float* outb = isctx ? out_ctx - (size_t)M_LAT * 1024 : out_lat;
        const int col = u.pn * 256 + wc * 32 + 8 * fq; const int row0 = u.pm * BM + wr * 64 + fr;
        f32x4 gv[2][2];
#pragma unroll
        for (int bj = 0; bj < 2; ++bj)
#pragma unroll
            for (int n = 0; n < 2; ++n) gv[bj][n] = *(const f32x4*)(gate + (size_t)modrow * 6144 + col + bj * HALF + 4 * n) * gscale;
        f32x4 cur[2][2], nxt[2][2];
#pragma unroll
        for (int bj = 0; bj < 2; ++bj)
#pragma unroll
            for (int n = 0; n < 2; ++n) cur[bj][n] = *(const f32x4*)(inb + (size_t)row0 * 1024 + col + bj * HALF + 4 * n);
#pragma unroll
        for (int it = 0; it < 8; ++it) { const int ai = it >> 2, m = it & 3; const size_t off = (size_t)(row0 + ai * HALF + m * 16) * 1024 + col;
            if (it < 7) { const size_t offn = (size_t)(row0 + ((it + 1) >> 2) * HALF + ((it + 1) & 3) * 16) * 1024 + col;
#pragma unroll
                for (int bj = 0; bj < 2; ++bj)
#pragma unroll
                    for (int n = 0; n < 2; ++n) nxt[bj][n] = *(const f32x4*)(inb + offn + bj * HALF + 4 * n); }
#pragma unroll
            for (int bj = 0; bj < 2; ++bj)
#pragma unroll
                for (int n = 0; n < 2; ++n) { *(f32x4*)(outb + off + bj * HALF + 4 * n) = cur[bj][n] + gv[bj][n] * acc[ai][bj][m][n]; cur[bj][n] = nxt[bj][n]; }
            asm volatile("" ::: "memory"); }
    }
};
struct EpiPart {
    static constexpr bool PERM = false, AFTER_DRAIN = false;
    float* P;
    __device__ __forceinline__ void operator()(const f32x4 (&acc)[2][2][4][2], const Unit& u, int wr, int wc, int fr, int fq) const {
        const int col = u.pn * 256 + wc * 32 + 8 * fq; const int row0 = u.pm * BM + wr * 64 + fr;
#pragma unroll
        for (int ai = 0; ai < 2; ++ai)
#pragma unroll
            for (int m = 0; m < 4; ++m) { float* rp = P + (size_t)(row0 + ai * HALF + m * 16) * 1024 + col;
#pragma unroll
                for (int bj = 0; bj < 2; ++bj)
#pragma unroll
                    for (int n = 0; n < 2; ++n) *(f32x4*)(rp + bj * HALF + 4 * n) = acc[ai][bj][m][n]; }
    }
};
struct EpiGU {
    static constexpr bool PERM = false, AFTER_DRAIN = false;
    bf16_t* ACT;
    __device__ __forceinline__ void operator()(const f32x4 (&acc)[2][2][4][2], const Unit& u, int wr, int wc, int fr, int fq) const {
        const int row0 = u.pm * BM + wr * 64 + fr;
#pragma unroll
        for (int ai = 0; ai < 2; ++ai)
#pragma unroll
            for (int m = 0; m < 4; ++m) { bf16_t* rowp = ACT + (size_t)(row0 + ai * HALF + m * 16) * DFF + u.pn * 128 + wc * 32 + 8 * fq;
                float r[8];
#pragma unroll
                for (int n = 0; n < 2; ++n)
#pragma unroll
                    for (int e = 0; e < 4; ++e) { const float g = acc[ai][0][m][n][e], up = acc[ai][1][m][n][e]; r[4 * n + e] = g * sigmoidf_(g) * up; }
                u32x4 w; w.x = pk2(r[0], r[1]); w.y = pk2(r[2], r[3]); w.z = pk2(r[4], r[5]); w.w = pk2(r[6], r[7]);
                *(u32x4*)rowp = w; }
    }
};
struct EpiFM {
    static constexpr bool PERM = true, AFTER_DRAIN = false;
    bf16_t* FM; int rowbase0, rpb;
    __device__ __forceinline__ void operator()(const f32x4 (&acc)[2][2][4][2], const Unit& u, int wr, int wc, int fr, int fq) const {
        const int b = u.pn >> 1; const int ncol = (u.pn & 1) * 256 + wc * 32 + 8 * fq;
        const int r0 = rowbase0 + b * rpb + u.pm * BM + wr * 64 + fr;
#pragma unroll
        for (int ai = 0; ai < 2; ++ai)
#pragma unroll
            for (int m = 0; m < 4; ++m) { bf16_t* rowp = FM + (size_t)(r0 + ai * HALF + m * 16) * 512 + ncol;
#pragma unroll
                for (int bj = 0; bj < 2; ++bj) { const f32x4 v0 = acc[ai][bj][m][0], v1 = acc[ai][bj][m][1];
                    u32x4 w; w.x = pk2(v0[0], v0[1]); w.y = pk2(v0[2], v0[3]); w.z = pk2(v1[0], v1[1]); w.w = pk2(v1[2], v1[3]);
                    *(u32x4*)(rowp + bj * HALF) = w; } }
    }
};
}

#define XB_TMO      128
#define XB_XCNT(j)  (256  + 64 * (j))
#define XB_XSUB(j)  (1280 + 64 * (j))
#define XB_XGEN(j)  (2304 + 64 * (j))
#define XB_TOP      3328
#define XB_TOPGEN   3392
#define XCD_BAR_WORDS 3456
#define XB_SPIN_CAP (1u << 18)

__device__ __forceinline__ unsigned xb_ld(unsigned* p)              { return __hip_atomic_load(p, __ATOMIC_RELAXED, __HIP_MEMORY_SCOPE_AGENT); }
__device__ __forceinline__ unsigned xb_add(unsigned* p, unsigned v) { return __hip_atomic_fetch_add(p, v, __ATOMIC_RELAXED, __HIP_MEMORY_SCOPE_AGENT); }
__device__ __forceinline__ unsigned xb_xcc_id() { return (unsigned)__builtin_amdgcn_s_getreg((3 << 11) | 20) & 0xFu; }
#define XB_SPIN(cond, bar) do { unsigned _sp = 0; while (cond) { __builtin_amdgcn_s_sleep(1); \
    if ((++_sp & 255u) == 0u) { if (xb_ld(&(bar)[XB_TMO])) break; if (_sp > XB_SPIN_CAP) { atomicAdd(&(bar)[XB_TMO], 1u); break; } } } } while (0)

struct XcdBarrier {
    unsigned* bar; unsigned x;
    volatile LAS unsigned* st;
};

__device__ __forceinline__ XcdBarrier xcd_barrier_post(unsigned* bar, volatile LAS unsigned* st) {
    XcdBarrier b; b.bar = bar; b.x = xb_xcc_id(); b.st = st;
    if (threadIdx.x == 0) (void)xb_add(&bar[XB_XCNT(b.x)], 1u);
    return b;
}
__device__ __forceinline__ void xcd_barrier_complete(unsigned* bar, unsigned x, unsigned& nloc, unsigned& nx) {
    const unsigned G = gridDim.x * gridDim.y * gridDim.z;
    unsigned sum, cnt, mine, sp = 0u;
    for (;;) {
        sum = 0u; cnt = 0u; mine = 0u;
#pragma unroll
        for (unsigned j = 0; j < 16; ++j) { const unsigned c = xb_ld(&bar[XB_XCNT(j)]); sum += c; cnt += (c > 0u) ? 1u : 0u; mine = (j == x) ? c : mine; }
        if (sum == G) break;
        __builtin_amdgcn_s_sleep(1);
        if ((++sp & 255u) == 0u) { if (xb_ld(&bar[XB_TMO])) break; if (sp > XB_SPIN_CAP) { atomicAdd(&bar[XB_TMO], 1u); break; } }
    }
    nloc = mine > 0u ? mine : 1u; nx = cnt > 0u ? cnt : 1u;
}

__device__ __forceinline__ void xcd_barrier(const XcdBarrier& b) {
    asm volatile("s_waitcnt vmcnt(0)" ::: "memory");
    __syncthreads();
    if (threadIdx.x == 0) {
        unsigned* bar = b.bar;
        __builtin_amdgcn_s_waitcnt(0);
        unsigned nloc = b.st[0], nx = b.st[1];
        if (nloc == 0u) { xcd_barrier_complete(bar, b.x, nloc, nx); b.st[0] = nloc; b.st[1] = nx; }
        const unsigned old = xb_add(&bar[XB_XSUB(b.x)], 1u);
        const unsigned gen = old / nloc;
        if (old + 1u == (gen + 1u) * nloc) {
            __builtin_amdgcn_fence(__ATOMIC_RELEASE, "agent");
            asm volatile("s_waitcnt vmcnt(0)" ::: "memory");
            const unsigned og = xb_add(&bar[XB_TOP], 1u);
            const unsigned tg = og / nx;
            if (og + 1u == (tg + 1u) * nx) xb_add(&bar[XB_TOPGEN], 1u);
            else XB_SPIN(xb_ld(&bar[XB_TOPGEN]) == tg, bar);
            __builtin_amdgcn_fence(__ATOMIC_ACQUIRE, "agent");
            xb_add(&bar[XB_XGEN(b.x)], 1u);
            asm volatile("s_waitcnt vmcnt(0)" ::: "memory");
        } else {
            XB_SPIN(xb_ld(&bar[XB_XGEN(b.x)]) == gen, bar);
            __builtin_amdgcn_fence(__ATOMIC_ACQUIRE, "agent");
            asm volatile("s_waitcnt vmcnt(0)" ::: "memory");
        }
    }
    __syncthreads();
}

namespace att {
using bf16x8 = __attribute__((ext_vector_type(8))) short;
using s16x4 = __attribute__((ext_vector_type(4))) short;
using f32x16 = __attribute__((ext_vector_type(16))) float;
constexpr int SHM_V = 16384, SHM_K = 16384;
constexpr int SLOT = SHM_K + SHM_V, NSLOT = 4, OFF_LI = NSLOT * SLOT, ATT_LDS = OFF_LI + 2048;
#define KSWZ(row, colB) ((row) * 256 + ((colB) ^ (((row) & 7) << 4)))
#define SBAR() __builtin_amdgcn_sched_barrier(0)
__device__ __forceinline__ int crow(int r, int hi) { return (r & 3) + 8 * (r >> 2) + 4 * hi; }
__device__ __forceinline__ unsigned cvtpk(float lo, float hi) { return pk2(lo, hi); }
__device__ __forceinline__ int v_st(int k, int c) { const int kk = (k & ~0xC) | ((k & 4) << 1) | ((k & 8) >> 1); return ((kk >> 3) * 4 + (c >> 5)) * 512 + ((kk & 7) * 32 + (c & 31)) * 2; }
__device__ __forceinline__ int v_rd_base(int lane) { return ((lane & 3) << 3) | (((lane >> 2) & 3) << 6) | (((lane >> 4) & 1) << 5) | (((lane >> 5) & 1) << 8); }
constexpr int v_rd_off(int d0, int ks, int half) { return d0 * 512 + ks * 4096 + half * 2048; }
template <int OFF> __device__ __forceinline__ s16x4 tr_read(int vb) { s16x4 r; asm volatile("ds_read_b64_tr_b16 %0, %1 offset:%2" : "=&v"(r) : "v"(vb), "i"(OFF) : "memory"); return r; }
template <int D0> __device__ __forceinline__ void pv_one(f32x16& od, int vb, const bf16x8* pa) {
    const s16x4 l0 = tr_read<v_rd_off(D0, 0, 0)>(vb), h0 = tr_read<v_rd_off(D0, 0, 1)>(vb), l1 = tr_read<v_rd_off(D0, 1, 0)>(vb), h1 = tr_read<v_rd_off(D0, 1, 1)>(vb);
    const s16x4 l2 = tr_read<v_rd_off(D0, 2, 0)>(vb), h2 = tr_read<v_rd_off(D0, 2, 1)>(vb), l3 = tr_read<v_rd_off(D0, 3, 0)>(vb), h3 = tr_read<v_rd_off(D0, 3, 1)>(vb);
    asm volatile("s_waitcnt lgkmcnt(0)" ::: "memory"); SBAR();
#define PK(L, H) (bf16x8){L[0], L[1], L[2], L[3], H[0], H[1], H[2], H[3]}
    od = __builtin_amdgcn_mfma_f32_32x32x16_bf16(pa[0], PK(l0, h0), od, 0, 0, 0);
    od = __builtin_amdgcn_mfma_f32_32x32x16_bf16(pa[1], PK(l1, h1), od, 0, 0, 0);
    od = __builtin_amdgcn_mfma_f32_32x32x16_bf16(pa[2], PK(l2, h2), od, 0, 0, 0);
    od = __builtin_amdgcn_mfma_f32_32x32x16_bf16(pa[3], PK(l3, h3), od, 0, 0, 0);
#undef PK
}
__device__ __forceinline__ void smx(f32x16& p0, f32x16& p1, float& l_acc, bf16x8* pa) {
#pragma unroll
    for (int r = 0; r < 16; ++r) { p0[r] = __builtin_amdgcn_exp2f(p0[r]); p1[r] = __builtin_amdgcn_exp2f(p1[r]); }
    float ps = 0.f;
#pragma unroll
    for (int r = 0; r < 16; ++r) ps += p0[r] + p1[r];
    l_acc += ps;
#define PK4(P, BASE, OUT) do { unsigned a0 = cvtpk(P[BASE + 0], P[BASE + 1]), a1 = cvtpk(P[BASE + 2], P[BASE + 3]);   \
    unsigned b0 = cvtpk(P[BASE + 4], P[BASE + 5]), b1 = cvtpk(P[BASE + 6], P[BASE + 7]);                              \
    auto r0 = __builtin_amdgcn_permlane32_swap(a0, b0, false, false); auto r1 = __builtin_amdgcn_permlane32_swap(a1, b1, false, false); \
    u32x4 w = {r0[0], r1[0], r0[1], r1[1]}; OUT = *reinterpret_cast<bf16x8*>(&w); } while (0)
    PK4(p0, 0, pa[0]); PK4(p0, 8, pa[1]); PK4(p1, 0, pa[2]); PK4(p1, 8, pa[3]);
#undef PK4
}
template <int Q> __device__ __forceinline__ void smxq(f32x16& p0, f32x16& p1, float& l_acc, bf16x8& out) {
    f32x16& P = (Q < 2) ? p0 : p1; constexpr int B = (Q & 1) * 8;
#pragma unroll
    for (int r = 0; r < 8; ++r) P[B + r] = __builtin_amdgcn_exp2f(P[B + r]);
    l_acc += ((P[B + 0] + P[B + 1]) + (P[B + 2] + P[B + 3])) + ((P[B + 4] + P[B + 5]) + (P[B + 6] + P[B + 7]));
    const unsigned a0 = cvtpk(P[B + 0], P[B + 1]), a1 = cvtpk(P[B + 2], P[B + 3]), b0 = cvtpk(P[B + 4], P[B + 5]), b1 = cvtpk(P[B + 6], P[B + 7]);
    auto r0 = __builtin_amdgcn_permlane32_swap(a0, b0, false, false); auto r1 = __builtin_amdgcn_permlane32_swap(a1, b1, false, false);
    u32x4 w = {r0[0], r1[0], r0[1], r1[1]}; out = *reinterpret_cast<bf16x8*>(&w);
}
template <bool DRY> __device__ __forceinline__ void attn_unit(const bf16_t* Qw_, const bf16_t* Kc, const bf16_t* Vc, const bf16_t* Kl, const bf16_t* Vl, int NT,
                                          bf16_t* Ow_, float lam, float negM, const float* subg, float oscale, char* lds, const int wave_s_) {
    const int tid = threadIdx.x, wid = __builtin_amdgcn_readfirstlane(tid >> 6), lane = tid & 63, r32 = lane & 31, hi = lane >> 5, rg = wid & 3, br = wid >> 2;
    float* li = (float*)(lds + OFF_LI) + wid * 64;
    float l_acc = 0.f; f32x16 o[4]; bf16x8 qr[4];
#pragma unroll
    for (int d = 0; d < 4; ++d)
#pragma unroll
        for (int r = 0; r < 16; ++r) o[d][r] = 0.f;
    { const bf16_t* Qw = Qw_ + (size_t)(rg * 32 + r32) * 1024 + br * 64 + hi * 8;
#pragma unroll
      for (int d0 = 0; d0 < 4; ++d0) qr[d0] = *reinterpret_cast<const bf16x8*>(Qw + d0 * 16); }
    int kofs[2], vofs[2];
#pragma unroll
    for (int i = 0; i < 2; ++i) { const int c = 2 * wid + i;
        { const int row = 4 * c + (lane >> 4), colB = ((lane & 15) * 16) ^ ((row & 7) << 4); kofs[i] = row * 1024 + (colB >> 1); }
        { const int sub = 2 * c + (lane >> 5), kk = (sub >> 2) * 8 + ((lane & 31) >> 2), k = (kk & ~0xC) | ((kk & 4) << 1) | ((kk & 8) >> 1), col = (sub & 3) * 32 + (lane & 3) * 8; vofs[i] = k * 1024 + col; } }
    typedef __attribute__((address_space(3))) unsigned las_u32;
    las_u32* ring = (las_u32*)(__attribute__((address_space(3))) char*)lds;
#define DMA_TILE(j, slot) do { const bf16_t* kb_ = ((j) < 4) ? Kc + (size_t)(j) * 65536 : Kl + (size_t)((j) - 4) * 65536; \
    const bf16_t* vb_ = ((j) < 4) ? Vc + (size_t)(j) * 65536 : Vl + (size_t)((j) - 4) * 65536; \
    __builtin_amdgcn_global_load_lds((const unsigned*)(kb_ + kofs[0]), ring + ((slot) * SLOT + (2 * wid) * 1024) / 4, 16, 0, 0); \
    __builtin_amdgcn_global_load_lds((const unsigned*)(kb_ + kofs[1]), ring + ((slot) * SLOT + (2 * wid + 1) * 1024) / 4, 16, 0, 0); \
    __builtin_amdgcn_global_load_lds((const unsigned*)(vb_ + vofs[0]), ring + ((slot) * SLOT + SHM_K + (2 * wid) * 1024) / 4, 16, 0, 0); \
    __builtin_amdgcn_global_load_lds((const unsigned*)(vb_ + vofs[1]), ring + ((slot) * SLOT + SHM_K + (2 * wid + 1) * 1024) / 4, 16, 0, 0); } while (0)
    const int vb0 = (int)(uintptr_t)lds + SHM_K + v_rd_base(lane);
    DMA_TILE(0, 0); DMA_TILE(1, 1);
    asm volatile("s_waitcnt vmcnt(4) lgkmcnt(0)\n\ts_barrier" ::: "memory");
#define QK_TILE(Kt_) do { \
        _Pragma("unroll") for (int r = 0; r < 16; ++r) { p0[r] = negM; p1[r] = negM; } \
        _Pragma("unroll") for (int d0 = 0; d0 < 4; ++d0) { const int cb = (br * 64 + d0 * 16 + hi * 8) * 2; \
            const bf16x8 b0 = *reinterpret_cast<const bf16x8*>((Kt_) + KSWZ(r32, cb)); \
            const bf16x8 b1 = *reinterpret_cast<const bf16x8*>((Kt_) + KSWZ(32 + r32, cb)); \
            p0 = __builtin_amdgcn_mfma_f32_32x32x16_bf16(b0, qr[d0], p0, 0, 0, 0); \
            p1 = __builtin_amdgcn_mfma_f32_32x32x16_bf16(b1, qr[d0], p1, 0, 0, 0); } } while (0)
    bf16x8 pa[4];
    { f32x16 p0, p1; QK_TILE(lds); smx(p0, p1, l_acc, pa); }
    DMA_TILE(2, 2);
    asm volatile("s_waitcnt vmcnt(4) lgkmcnt(0)\n\ts_barrier" ::: "memory");
    int slot = 1;
    for (int j = 1; j < NT; ++j) {
        if (j + 2 < NT) DMA_TILE(j + 2, (slot + 2) & 3);
        const char* Kt = lds + slot * SLOT; const int vbp = vb0 + ((slot + 3) & 3) * SLOT;
        f32x16 p0, p1; bf16x8 pn[4];
        QK_TILE(Kt);
        SBAR();
        pv_one<0>(o[0], vbp, pa); smxq<0>(p0, p1, l_acc, pn[0]); SBAR();
        pv_one<1>(o[1], vbp, pa); smxq<1>(p0, p1, l_acc, pn[1]); SBAR();
        pv_one<2>(o[2], vbp, pa); smxq<2>(p0, p1, l_acc, pn[2]); SBAR();
        pv_one<3>(o[3], vbp, pa); smxq<3>(p0, p1, l_acc, pn[3]); SBAR();
        pa[0] = pn[0]; pa[1] = pn[1]; pa[2] = pn[2]; pa[3] = pn[3];
        if (j + 2 < NT) asm volatile("s_waitcnt vmcnt(4) lgkmcnt(0)\n\ts_barrier" ::: "memory");
        else asm volatile("s_waitcnt vmcnt(0) lgkmcnt(0)\n\ts_barrier" ::: "memory");
        slot = (slot + 1) & 3;
    }
    { const int vbp = vb0 + ((slot + 3) & 3) * SLOT;
      pv_one<0>(o[0], vbp, pa); pv_one<1>(o[1], vbp, pa); pv_one<2>(o[2], vbp, pa); pv_one<3>(o[3], vbp, pa); }
#undef QK_TILE
#undef DMA_TILE
    if constexpr (DRY) { if (o[0][0] == 12345.678f) Ow_[lane] = 0; __syncthreads(); return; }
    { auto rr = __builtin_amdgcn_permlane32_swap(__float_as_uint(l_acc), __float_as_uint(l_acc), false, false); l_acc = __uint_as_float(rr[0]) + __uint_as_float(rr[1]); }
    if (hi == 0) li[r32] = l_acc;
    asm volatile("s_waitcnt lgkmcnt(0)" ::: "memory");
    float* xch = (float*)lds + (size_t)rg * 4096;
    const float lscale = br ? lam : 1.f;
#pragma unroll
    for (int r = 0; r < 16; ++r) { const float a = lscale * __builtin_amdgcn_rcpf(li[crow(r, hi)]);
#pragma unroll
        for (int d = 0; d < 4; ++d) o[d][r] *= a; }
    if (br == 1) {
#pragma unroll
        for (int r = 0; r < 16; ++r)
#pragma unroll
            for (int d = 0; d < 4; ++d) xch[(r * 4 + d) * 64 + lane] = o[d][r];
    }
    __syncthreads();
    if (br == 0) {
        float ss[16];
#pragma unroll
        for (int r = 0; r < 16; ++r) { float s = 0.f;
#pragma unroll
            for (int d = 0; d < 4; ++d) { const float v = o[d][r] - xch[(r * 4 + d) * 64 + lane]; o[d][r] = v; s += v * v; }
            ss[r] = s; }
#pragma unroll
        for (int off = 1; off < 32; off <<= 1)
#pragma unroll
            for (int r = 0; r < 16; ++r) ss[r] += __shfl_xor(ss[r], off);
        float sg[4];
#pragma unroll
        for (int d = 0; d < 4; ++d) sg[d] = subg[d * 32 + r32] * oscale;
        bf16_t* stg = (bf16_t*)(lds + 65536 + rg * 8192);
#pragma unroll
        for (int r = 0; r < 16; ++r) { const float rn = rsqrtf(ss[r] * (1.f / 128.f) + EPS); const int orow = crow(r, hi);
#pragma unroll
            for (int d = 0; d < 4; ++d) stg[orow * 128 + d * 32 + r32] = (bf16_t)f2bf(o[d][r] * rn * sg[d]); }
        asm volatile("s_waitcnt lgkmcnt(0)" ::: "memory");
        bf16_t* Ow = Ow_ + (size_t)(rg * 32) * 1024;
#pragma unroll
        for (int i = 0; i < 8; ++i) { const int row = i * 4 + (lane >> 4), ch = lane & 15;
            const u32x4 v = *(const u32x4*)(stg + row * 128 + ch * 8);
            *(u32x4*)(Ow + (size_t)row * 1024 + ch * 8) = v; }
    }
    __syncthreads();
}
#undef SBAR
}

__device__ __forceinline__ int colmap(int id, int rho) {
    const int local = rho & 255, hi_ = rho & ~255;
    const int s8 = (rho & ~31) | (((rho >> 2) & 3) << 3) | (((rho >> 4) & 1) << 2) | (rho & 3);
    if (id == 2) return s8;
    if (id == 1) return 3584 + s8;
    if (id == 0) { if ((rho >> 10) == 1) return s8; const int bj = local >> 7, wc = (local >> 5) & 3, rest = local & 31; return hi_ + 64 * wc + 32 * bj + rest; }
    { const int pn = rho >> 8, bj = local >> 7; return bj * DFF + 128 * pn + (s8 & 127); }
}
__device__ __forceinline__ void tr_item(const float* W, int K, int N, bf16_t* WT, int nrb, int id, LAS float* scr, int item, int lane) {
    const int kb = item / nrb, rb = item % nrb, k0 = 64 * kb, r0 = 32 * rb;
    const int c = colmap(id, r0 + (lane & 31));
    float wv[32];
#pragma unroll
    for (int i = 0; i < 32; ++i) wv[i] = W[(size_t)(k0 + 2 * i + (lane >> 5)) * N + c];
#pragma unroll
    for (int i = 0; i < 32; ++i) scr[(2 * i + (lane >> 5)) * 33 + (lane & 31)] = wv[i];
    asm volatile("s_waitcnt lgkmcnt(0)" ::: "memory");
    const int ch = lane & 7;
#pragma unroll
    for (int j = 0; j < 4; ++j) { const int n = (lane >> 3) + 8 * j; const LAS float* s = scr + (8 * ch) * 33 + n;
        u32x4 o; o.x = pk2(s[0 * 33], s[1 * 33]); o.y = pk2(s[2 * 33], s[3 * 33]); o.z = pk2(s[4 * 33], s[5 * 33]); o.w = pk2(s[6 * 33], s[7 * 33]);
        *(u32x4*)(WT + (size_t)(r0 + n) * K + k0 + 8 * ch) = o; }
    asm volatile("s_waitcnt lgkmcnt(0)" ::: "memory");
}

struct Args { const float* in[21]; float* out; unsigned char* ws; int ph_lo, ph_hi; };
enum { I_X = 0, I_C, I_CTX, I_CCTX, I_WADA, I_BADA, I_N1G, I_N2G, I_WIN, I_QNG, I_KNG, I_LQ1, I_LK1, I_LQ2, I_LK2, I_SUBG, I_WPA, I_WPF, I_WOUT, I_WGU, I_WD };
constexpr int N_PHASES = 19;
#ifndef ONLY_S
#define ONLY_S -1
#endif
constexpr int only_s = ONLY_S;
#define PS(n) ((only_s < 0 || only_s == (n)) && s == (n))

__device__ __forceinline__ void norm_rows(const float* lat, const float* ctx, const float* g, const float* mod, int shidx, int scidx, bf16_t* H, int M, int gw, int NGW, int lane, const float* PP = nullptr, const float* pgate = nullptr) {
    for (int row = gw; row < M; row += NGW) {
        const float* src = row < M_LAT ? lat + (size_t)row * 1024 : ctx + (size_t)(row - M_LAT) * 1024;
        const int modrow = row < M_LAT ? (row >> 11) : 16;
        const f32x4* xr = (const f32x4*)src + lane;
        f32x4 v[4]; float ss = 0.f;
#pragma unroll
        for (int j = 0; j < 4; ++j) { v[j] = xr[64 * j];
            if (PP && row >= M_LAT) { const f32x4* pa = (const f32x4*)(PP + (size_t)(row - M_LAT) * 1024) + lane; const f32x4* pb = pa + (size_t)M_CTX * 256;
                v[j] += *((const f32x4*)pgate + lane + 64 * j) * (pa[64 * j] + pb[64 * j]); }
            ss += (v[j].x * v[j].x + v[j].y * v[j].y) + (v[j].z * v[j].z + v[j].w * v[j].w); }
        const float rinv = rsqrtf(wave_sum(ss) * (1.f / 1024.f) + EPS);
        const float* mr = mod + (size_t)modrow * 6144;
        u32x2* o8 = (u32x2*)(H + (size_t)row * 1024) + lane;
#pragma unroll
        for (int j = 0; j < 4; ++j) { const int col = 4 * (lane + 64 * j);
            const f32x4 gg = *(const f32x4*)(g + col), sc = *(const f32x4*)(mr + scidx * 1024 + col), sh = *(const f32x4*)(mr + shidx * 1024 + col);
            const f32x4 h = v[j] * rinv * gg * (sc + 1.f) + sh;
            u32x2 w; w.x = pk2(h.x, h.y); w.y = pk2(h.z, h.w); o8[64 * j] = w; }
    }
}

#ifndef MK_XBAR
#define MK_XBAR 1
#endif
#ifndef MK_SP2
#define MK_SP2 false
#endif
#ifndef MK_ALIGN
#define MK_ALIGN false
#endif
#ifndef MK_ALIGN_RES
#define MK_ALIGN_RES MK_ALIGN
#endif
#ifndef MK_ALIGN_KVQ
#define MK_ALIGN_KVQ MK_ALIGN
#endif
struct Ctx { int G, bx, vcu, gw, NGW, lane, tid, wave; };

typedef const __attribute__((address_space(4))) Args* KArgP;
#define KARGS() ((KArgP)__builtin_amdgcn_kernarg_segment_ptr())
__device__ __forceinline__ void p0_phase(LAS unsigned char* lds3, const Ctx& c) {
    KArgP ap = KARGS();
    unsigned char* ws = ap->ws; const int tid = c.tid, lane = c.lane, wave = c.wave, G = c.G, vcu = c.vcu;
    float* SM = (float*)(ws + OFF_LAM); float* ROPE = (float*)(ws + OFF_ROPE); float* MOD = (float*)(ws + OFF_MOD);
    bf16_t* DFT = (bf16_t*)(ws + WS_DFT); bf16_t* DFTC = (bf16_t*)(ws + WS_DFTC);
    LAS float* tab = (LAS float*)(lds3 + 110592);
    for (int i = tid; i < 2048; i += 512) tab[i] = cospif((float)i * (1.f / 1024.f));
    __syncthreads();
#ifndef SKIP_P0A
    { LAS float* scr = (LAS float*)(lds3 + wave * 8448);
      constexpr int PER_L = 8064;
      for (int it = c.gw; it < 2 * PER_L; it += c.NGW) {
          const int l = it / PER_L; int r = it % PER_L;
          unsigned char* wl = ws + WS_W + (size_t)l * W_LSTRIDE;
          const float* win = ap->in[I_WIN] + (size_t)l * 1024 * INW;
          if (r < 1536) { tr_item(win, 1024, INW, (bf16_t*)(wl + W_KVQ), 96, 0, scr, r, lane); continue; } r -= 1536;
          if (r < 1024) { tr_item(win, 1024, INW, (bf16_t*)(wl + W_G), 64, 1, scr, r, lane); continue; } r -= 1024;
          if (r < 512) { tr_item(ap->in[I_WPA] + (size_t)l * 1024 * 1024, 1024, 1024, (bf16_t*)(wl + W_PA), 32, 2, scr, r, lane); continue; } r -= 512;
          if (r < 256) { tr_item(ap->in[I_WPF] + (size_t)l * 512 * 1024, 512, 1024, (bf16_t*)(wl + W_PF), 32, 2, scr, r, lane); continue; } r -= 256;
          if (r < 512) { tr_item(ap->in[I_WOUT] + (size_t)l * 1024 * 1024, 1024, 1024, (bf16_t*)(wl + W_OUT), 32, 2, scr, r, lane); continue; } r -= 512;
          if (r < 2816) { tr_item(ap->in[I_WGU] + (size_t)l * 1024 * 2 * DFF, 1024, 2 * DFF, (bf16_t*)(wl + W_GU), 176, 3, scr, r, lane); continue; } r -= 2816;
          tr_item(ap->in[I_WD] + (size_t)l * DFF * 1024, DFF, 1024, (bf16_t*)(wl + W_D), 32, 2, scr, r, lane);
      } }
    __syncthreads();
#endif
#ifndef SKIP_P0B
    { LAS float* wt = (LAS float*)lds3;
      for (int it = vcu; it < 256; it += G) {
          const int l = it >> 7, g = (it >> 5) & 3, kb = it & 31, k0 = kb * 32;
          const float* win = ap->in[I_WIN] + (size_t)l * 1024 * INW + 3072 + g * 128;
          for (int i = tid; i < 32 * 128; i += 512) { const int kk = i >> 7, cc = i & 127; wt[kk * 129 + cc] = win[(size_t)(k0 + kk) * INW + cc]; }
          __syncthreads();
          bf16_t* wf = (bf16_t*)(ws + WS_W + (size_t)l * W_LSTRIDE + W_F);
          const int kk = tid & 31, cg0 = (tid >> 5) * 4;
          for (int cc = 0; cc < 4; ++cc) { const int cp = cg0 + cc; float ac = 0.f, as = 0.f, a64 = 0.f;
              for (int ci = 0; ci < 128; ++ci) { const int idx = ((ci * cp) & 127) * 16; const float w = wt[kk * 129 + ci]; ac += w * tab[idx]; as += w * tab[(idx - 512) & 2047]; a64 += (ci & 1) ? -w : w; }
              const int r = 2 * (g * 64 + cp);
              wf[(size_t)r * 1024 + k0 + kk] = (bf16_t)f2bf(ac * 0.08838834764831845f);
              wf[(size_t)(r + 1) * 1024 + k0 + kk] = (bf16_t)f2bf((cp == 0 ? a64 : as) * 0.08838834764831845f);
              if (l == 0) { bf16_t* wc_ = (bf16_t*)(ws + WS_WFC) + k0 + kk;
                  const unsigned uc = f2bf(ac * 0.08838834764831845f), us = f2bf(as * 0.08838834764831845f);
                  if (cp == 0) { wc_[(size_t)(2 * (g * 128)) * 1024] = (bf16_t)uc; wc_[(size_t)(2 * (g * 128) + 1) * 1024] = 0;
                                 wc_[(size_t)(2 * (g * 128 + 64)) * 1024] = (bf16_t)f2bf(a64 * 0.08838834764831845f); wc_[(size_t)(2 * (g * 128 + 64) + 1) * 1024] = 0; }
                  else { wc_[(size_t)(2 * (g * 128 + cp)) * 1024] = (bf16_t)uc; wc_[(size_t)(2 * (g * 128 + cp) + 1) * 1024] = (bf16_t)us;
                         wc_[(size_t)(2 * (g * 128 + 128 - cp)) * 1024] = (bf16_t)uc; wc_[(size_t)(2 * (g * 128 + 128 - cp) + 1) * 1024] = (bf16_t)(us ^ 0x8000u); } } }
          __syncthreads();
      } }
#endif
#ifndef SKIP_P0C
    { const int gt = vcu * 512 + tid, NGT = G * 512;
      for (int idx = gt; idx < 2048 * (ZK / 8); idx += NGT) { const int tp = idx / (ZK / 8), k8 = (idx % (ZK / 8)) * 8; float v[8];
#pragma unroll
          for (int e = 0; e < 8; ++e) { const int k = k8 + e; float x;
              if (k < 1024) x = tab[(k * tp) & 2047];
              else if (k < 2048) x = -tab[((((k - 1024) * tp) & 2047) - 512) & 2047];
              else if (k == 2048) x = (tp & 1) ? -1.f : 1.f;
              else x = 0.f;
              v[e] = x * 0.022097086912079608f; }
          u32x4 w; w.x = pk2(v[0], v[1]); w.y = pk2(v[2], v[3]); w.z = pk2(v[4], v[5]); w.w = pk2(v[6], v[7]);
          *(u32x4*)(DFT + (size_t)tp * ZK + k8) = w; }
      for (int idx = gt; idx < 256 * 64; idx += NGT) { const int tp = idx >> 6, k8 = (idx & 63) * 8; float v[8];
#pragma unroll
          for (int e = 0; e < 8; ++e) { const int k = k8 + e, cs = k >> 8, t = k & 255, aa = ((t * tp) & 255) * 8; v[e] = (cs ? -tab[(aa - 512) & 2047] : tab[aa]) * 0.0625f; }
          u32x4 w; w.x = pk2(v[0], v[1]); w.y = pk2(v[2], v[3]); w.z = pk2(v[4], v[5]); w.w = pk2(v[6], v[7]);
          *(u32x4*)(DFTC + (size_t)tp * 512 + k8) = w; } }
#endif
#ifndef SKIP_P0D
    if (c.bx == G - 1) {
        for (int i = tid; i < 1024; i += 512) { const int pos = i >> 4, f = i & 15; const float invf = powf(10000.f, -(float)f * (1.f / 16.f)); const float ang = (float)pos * invf;
            ROPE[i] = cosf(ang); ROPE[1024 + i] = sinf(ang); }
        if (tid < 2) { const int l = tid; float s1 = 0.f, s2 = 0.f, mq = 0.f, mk = 0.f;
            for (int i = 0; i < 64; ++i) { s1 += ap->in[I_LQ1][l * 64 + i] * ap->in[I_LK1][l * 64 + i]; s2 += ap->in[I_LQ2][l * 64 + i] * ap->in[I_LK2][l * 64 + i];
                mq = fmaxf(mq, fabsf(ap->in[I_QNG][l * 64 + i])); mk = fmaxf(mk, fabsf(ap->in[I_KNG][l * 64 + i])); }
            const float lam_init = 0.8f - 0.6f * expf(-0.3f * (float)l);
            SM[l] = expf(s1) - expf(s2) + lam_init; SM[2 + l] = -(8.f * mq * mk * LOG2E); SM[4 + l] = lam_init; }
    }
    __syncthreads();
#endif
#ifndef SKIP_P0E
    { LAS float* sl = (LAS float*)lds3;
      LAS float* part = (LAS float*)(lds3 + 69632);
      for (int i = tid; i < 17 * 1024; i += 512) { const int b = i >> 10, k = i & 1023; const float cv = b < 16 ? ap->in[I_C][b * 1024 + k] : ap->in[I_CCTX][k]; sl[i] = cv * sigmoidf_(cv); }
      __syncthreads();
      for (int it = vcu; it < 192; it += G) {
          const int l = it / 96, n0 = (it % 96) * 64;
          const float* wa = ap->in[I_WADA] + (size_t)l * 1024 * 6144 + n0 + lane;
          float acc[17];
#pragma unroll
          for (int b = 0; b < 17; ++b) acc[b] = 0.f;
#pragma unroll 4
          for (int kk = 0; kk < 128; ++kk) { const int k = wave * 128 + kk; const float w = wa[(size_t)k * 6144];
#pragma unroll
              for (int b = 0; b < 17; ++b) acc[b] += w * sl[b * 1024 + k]; }
#pragma unroll
          for (int b = 0; b < 17; ++b) part[(wave * 17 + b) * 64 + lane] = acc[b];
          __syncthreads();
          for (int i = tid; i < 17 * 64; i += 512) { const int b = i >> 6, n = i & 63; float v = ap->in[I_BADA][l * 6144 + n0 + n];
#pragma unroll
              for (int w = 0; w < 8; ++w) v += part[(w * 17 + b) * 64 + n];
              MOD[((size_t)l * 17 + b) * 6144 + n0 + n] = v; }
          __syncthreads();
      } }
#endif
}

template <int L, int S> __device__ __forceinline__ void run_phase(unsigned char* lds, const Ctx& c) {
    KArgP ap = KARGS();
    LAS unsigned char* lds3 = (LAS unsigned char*)lds;
    unsigned char* ws = ap->ws; const int G = c.G, bx = c.bx;
    float* SM = (float*)(ws + OFF_LAM); float* ROPE = (float*)(ws + OFF_ROPE); float* MOD = (float*)(ws + OFF_MOD);
    bf16_t* DFT = (bf16_t*)(ws + WS_DFT); bf16_t* DFTC = (bf16_t*)(ws + WS_DFTC);
    float* RC = (float*)(ws + WS_RC);
    bf16_t* Hb = (bf16_t*)(ws + WS_H); bf16_t* Qb = (bf16_t*)(ws + WS_Q); bf16_t* Kb = (bf16_t*)(ws + WS_K); bf16_t* Vb = (bf16_t*)(ws + WS_V);
    bf16_t* YT = (bf16_t*)(ws + WS_YT); bf16_t* YTC = (bf16_t*)(ws + WS_YTC); bf16_t* FM = (bf16_t*)(ws + WS_FM);
    bf16_t* Gb = Kb;
    bf16_t* ACT = Qb;
    bf16_t* MG = Hb;
    unsigned char* wl = ws + WS_W + (size_t)L * W_LSTRIDE;
    const float* modl = MOD + (size_t)L * 17 * 6144;
    constexpr int Mrows = (L == 0) ? M_ALL : M_LAT;
    const float* rin_lat = (L == 0) ? ap->in[I_X] : ap->out; const float* rin_ctx = (L == 0) ? ap->in[I_CTX] : RC;
    if constexpr (S == 0) {
        if constexpr (L == 1) norm_rows(rin_lat, rin_ctx, ap->in[I_N1G] + L * 1024, modl, 0, 1, Hb, M_ALL, c.gw, c.NGW, c.lane, (const float*)(ws + WS_FM), MOD + (size_t)16 * 6144 + 5 * 1024);
        else norm_rows(rin_lat, rin_ctx, ap->in[I_N1G] + L * 1024, modl, 0, 1, Hb, M_ALL, c.gw, c.NGW, c.lane);
    } else if constexpr (S == 1) {
        { LAS float* tabl = (LAS float*)(lds3 + 131072);
          for (int i = c.tid; i < 2048; i += 512) tabl[i] = ROPE[i];
          if (c.tid < 64) { tabl[2048 + c.tid] = ap->in[I_KNG][L * 64 + c.tid]; tabl[2112 + c.tid] = ap->in[I_QNG][L * 64 + c.tid]; }
          __syncthreads(); }
        { pg8::Gemm g{Hb, (const bf16_t*)(wl + W_KVQ), M_ALL, 3072, 1024}; pg8::StaticOrder St; St.init(M_ALL, 3072, G, bx);
          ep::EpiKVQ E{Kb, Vb, Qb, (const LAS float*)(lds3 + 131072)};
          pg8::gemm_phase<ep::EpiKVQ, pg8::StaticOrder, MK_ALIGN_KVQ, MK_SP2>(lds3, g, St, E, c.wave); }
        { pg8::Gemm g{(const bf16_t*)(wl + W_F), Hb, 512, M_LAT, 1024}; pg8::StaticOrder St; St.init(512, M_LAT, G, bx);
          ep::EpiYTm E{YT};
          pg8::gemm_phase<ep::EpiYTm, pg8::StaticOrder, MK_ALIGN, MK_SP2, 1>(lds3, g, St, E, c.wave); }
#ifndef NO_CTXG2
        if constexpr (L == 0) {
          pg8::Gemm g{(const bf16_t*)(ws + WS_WFC), Hb + (size_t)M_LAT * 1024, 1024, M_CTX, 1024}; pg8::StaticOrder St; St.init(1024, M_CTX, G, G - 1 - bx);
          ep::EpiYTc E{YTC};
          pg8::gemm_phase<ep::EpiYTc, pg8::StaticOrder, MK_ALIGN, MK_SP2>(lds3, g, St, E, c.wave); }
#endif
        { const bf16_t* Wf = (const bf16_t*)(wl + W_F);
          for (int it = c.gw; it < 16 * 512; it += c.NGW) { const int b = it >> 9, n = it & 511;
              const bf16_t* hrow = Hb + (size_t)(b * 2048 + 1024) * 1024 + c.lane * 16; const int gq = n >> 7, cq = n & 127, cm = cq <= 64 ? cq : 128 - cq; const bf16_t* wrow = Wf + (size_t)(cm == 64 ? 2 * (gq * 64) + 1 : 2 * (gq * 64 + cm)) * 1024 + c.lane * 16;
              const u32x4 h0 = *(const u32x4*)hrow, h1 = *(const u32x4*)(hrow + 8), w0 = *(const u32x4*)wrow, w1 = *(const u32x4*)(wrow + 8);
              float s = 0.f;
#pragma unroll
              for (int e = 0; e < 4; ++e) { s += bflo(h0[e]) * bflo(w0[e]) + bfhi(h0[e]) * bfhi(w0[e]); s += bflo(h1[e]) * bflo(w1[e]) + bfhi(h1[e]) * bfhi(w1[e]); }
              s = wave_sum(s);
              ((unsigned*)(YT + ((size_t)(b * 512 + n)) * ZK + 2048))[c.lane] = (c.lane == 0) ? f2bf(s) : 0u; } }
    } else if constexpr (S == 2) {
#ifndef SKIP_ATT
        const float lam = SM[L], negM = SM[2 + L], lam_init = SM[4 + L];
        constexpr int nunits = 2048 + (L == 0 ? 256 : 0);
        for (int u = c.vcu; u < nunits; u += G) {
            int b, h, qrow0, NT;
            if (u < 2048) { const int bh = u >> 4, qb = u & 15; b = bh >> 3; h = bh & 7; qrow0 = b * SEQ + qb * 128; NT = 36; }
            else { const int uc = u - 2048, bh = uc >> 1; b = bh >> 3; h = bh & 7; qrow0 = M_LAT + b * CTXL + (uc & 1) * 128; NT = 4; }
            const size_t crow0 = (size_t)(M_LAT + b * CTXL) * 1024 + h * 128, lrow0 = (size_t)(b * SEQ) * 1024 + h * 128;
#ifdef DBL_ATT
            att::attn_unit<true>(Qb + (size_t)qrow0 * 1024 + h * 128, Kb + crow0, Vb + crow0, Kb + lrow0, Vb + lrow0, NT,
                           Qb + (size_t)qrow0 * 1024 + h * 128, lam, negM, ap->in[I_SUBG] + L * 128, 1.f - lam_init, (char*)lds, c.wave);
#endif
            att::attn_unit<false>(Qb + (size_t)qrow0 * 1024 + h * 128, Kb + crow0, Vb + crow0, Kb + lrow0, Vb + lrow0, NT,
                           Qb + (size_t)qrow0 * 1024 + h * 128, lam, negM, ap->in[I_SUBG] + L * 128, 1.f - lam_init, (char*)lds, c.wave);
        }
        __syncthreads();
#endif
        { pg8::Gemm g{DFT, YT, 2048, 8192, ZK}; pg8::StaticOrder St; St.init(2048, 8192, G, bx);
          ep::EpiFM E{FM, 0, SEQ};
          pg8::gemm_phase<ep::EpiFM, pg8::StaticOrder, MK_ALIGN, MK_SP2>(lds3, g, St, E, c.wave);
#ifdef DBL_FM
          pg8::gemm_phase<ep::EpiFM, pg8::StaticOrder, MK_ALIGN, MK_SP2>(lds3, g, St, E, c.wave);
#endif
        }
        if constexpr (L == 0) { pg8::Gemm g{DFTC, YTC, 256, 8192, 512}; pg8::StaticOrder St; St.init(256, 8192, G, bx);
          ep::EpiFM E{FM, M_LAT, CTXL};
          pg8::gemm_phase<ep::EpiFM, pg8::StaticOrder, MK_ALIGN, MK_SP2>(lds3, g, St, E, c.wave); }
    } else if constexpr (S == 3) {
        pg8::Gemm g{Hb, (const bf16_t*)(wl + W_G), Mrows, 2048, 1024}; pg8::StaticOrder St; St.init(Mrows, 2048, G, bx);
        ep::EpiGate E{Gb};
        pg8::gemm_phase<ep::EpiGate, pg8::StaticOrder, MK_ALIGN, MK_SP2>(lds3, g, St, E, c.wave);
    } else if constexpr (S == 4) {
        { pg8::Gemm g{Qb, (const bf16_t*)(wl + W_PA), Mrows, 1024, 1024}; pg8::StaticOrder St; St.init(Mrows, 1024, G, bx);
          ep::EpiMerge<false> E{MG, Gb, 0};
          pg8::gemm_phase<ep::EpiMerge<false>, pg8::StaticOrder, MK_ALIGN, MK_SP2>(lds3, g, St, E, c.wave); }
        { pg8::Gemm g{FM, (const bf16_t*)(wl + W_PF), Mrows, 1024, 512}; pg8::StaticOrder St; St.init(Mrows, 1024, G, bx);
          ep::EpiMerge<true> E{MG, Gb, 1024};
          pg8::gemm_phase<ep::EpiMerge<true>, pg8::StaticOrder, MK_ALIGN, MK_SP2>(lds3, g, St, E, c.wave); }
    } else if constexpr (S == 5) {
        pg8::Gemm g{MG, (const bf16_t*)(wl + W_OUT), Mrows, 1024, 1024}; pg8::StaticOrder St; St.init(Mrows, 1024, G, bx);
        ep::EpiRes E{rin_lat, rin_ctx, ap->out, RC, modl + 2 * 1024, 1.f};
        pg8::gemm_phase<ep::EpiRes, pg8::StaticOrder, MK_ALIGN_RES, MK_SP2>(lds3, g, St, E, c.wave);
    } else if constexpr (S == 6) {
        norm_rows(ap->out, RC, ap->in[I_N2G] + L * 1024, modl, 3, 4, Hb, Mrows, c.gw, c.NGW, c.lane);
    } else if constexpr (S == 7) {
        pg8::Gemm g{Hb, (const bf16_t*)(wl + W_GU), Mrows, 2 * DFF, 1024}; pg8::StaticOrder St; St.init(Mrows, 2 * DFF, G, bx);
        ep::EpiGU E{ACT};
        pg8::gemm_phase<ep::EpiGU, pg8::StaticOrder, MK_ALIGN, MK_SP2>(lds3, g, St, E, c.wave);
    } else {
        { pg8::Gemm g{ACT, (const bf16_t*)(wl + W_D), M_LAT, 1024, DFF}; pg8::StaticOrder St; St.init(M_LAT, 1024, G, bx);
          ep::EpiRes E{ap->out, RC, ap->out, RC, modl + 5 * 1024, 1.f};
          pg8::gemm_phase<ep::EpiRes, pg8::StaticOrder, MK_ALIGN_RES, MK_SP2>(lds3, g, St, E, c.wave); }
        if constexpr (L == 0) {
            float* PP = (float*)(ws + WS_FM);
            { pg8::Gemm g{ACT + (size_t)M_LAT * DFF, (const bf16_t*)(wl + W_D), M_CTX, 1024, DFF / 2, DFF}; pg8::StaticOrder St; St.init(M_CTX, 1024, G, G - 1 - bx);
              ep::EpiPart E{PP};
              pg8::gemm_phase<ep::EpiPart, pg8::StaticOrder, MK_ALIGN, MK_SP2>(lds3, g, St, E, c.wave); }
            { pg8::Gemm g{ACT + (size_t)M_LAT * DFF + DFF / 2, (const bf16_t*)(wl + W_D) + DFF / 2, M_CTX, 1024, DFF / 2, DFF}; pg8::StaticOrder St; St.init(M_CTX, 1024, G, (bx + 128) % G);
              ep::EpiPart E{PP + (size_t)M_CTX * 1024};
              pg8::gemm_phase<ep::EpiPart, pg8::StaticOrder, MK_ALIGN, MK_SP2>(lds3, g, St, E, c.wave); }
        }
    }
}

#ifndef NVGPR
#define NVGPR 256
#endif
#ifndef PH_MASK
#define PH_MASK 0x7ffff
#endif
__global__ void __launch_bounds__(512, 2) __attribute__((amdgpu_num_vgpr(NVGPR))) fwd_mega(Args a) {
    extern __shared__ __attribute__((aligned(16))) unsigned char lds[];
    cg::grid_group grid = cg::this_grid();
#define MAKE_CTX() Ctx c; { int t_ = threadIdx.x; asm volatile("" : "+v"(t_)); c.tid = t_; } c.lane = c.tid & 63; c.wave = __builtin_amdgcn_readfirstlane(c.tid >> 6); \
    c.G = gridDim.x; c.bx = blockIdx.x; c.vcu = (c.G % 8 == 0) ? (c.bx % 8) * (c.G / 8) + c.bx / 8 : c.bx; c.gw = c.vcu * 8 + c.wave; c.NGW = c.G * 8;
    const int lo = a.ph_lo, hi = a.ph_hi;
    { int t0_ = threadIdx.x; asm volatile("" : "+v"(t0_)); for (int i = t0_; i < LDS_BYTES / 16; i += 512) ((LAS u32x4*)lds)[i] = (u32x4){0u, 0u, 0u, 0u}; }
    __syncthreads();
    XcdBarrier xbar = xcd_barrier_post((unsigned*)(a.ws + OFF_XBAR), (volatile LAS unsigned*)((LAS unsigned char*)lds + LDS_BYTES - 64));
#ifndef DBL_SYNC
#define DBL_SYNC 0
#endif
#ifndef DBL_MASK
#define DBL_MASK 0
#endif
#define PH(k, body) if (((PH_MASK >> (k)) & 1) && lo <= (k) && (k) < hi) { if ((k) > lo) { if ((k) == 1 || !MK_XBAR) grid.sync(); else { xcd_barrier(xbar); if (DBL_SYNC) { xcd_barrier(xbar); xcd_barrier(xbar); } } } MAKE_CTX(); body; if constexpr (((DBL_MASK >> (k)) & 1) != 0) { __syncthreads(); body; } }
    PH(0, p0_phase((LAS unsigned char*)lds, c))
    PH(1, (run_phase<0, 0>(lds, c)))  PH(2, (run_phase<0, 1>(lds, c)))  PH(3, (run_phase<0, 2>(lds, c)))
    PH(4, (run_phase<0, 3>(lds, c)))  PH(5, (run_phase<0, 4>(lds, c)))  PH(6, (run_phase<0, 5>(lds, c)))
    PH(7, (run_phase<0, 6>(lds, c)))  PH(8, (run_phase<0, 7>(lds, c)))  PH(9, (run_phase<0, 8>(lds, c)))
    PH(10, (run_phase<1, 0>(lds, c))) PH(11, (run_phase<1, 1>(lds, c))) PH(12, (run_phase<1, 2>(lds, c)))
    PH(13, (run_phase<1, 3>(lds, c))) PH(14, (run_phase<1, 4>(lds, c))) PH(15, (run_phase<1, 5>(lds, c)))
    PH(16, (run_phase<1, 6>(lds, c))) PH(17, (run_phase<1, 7>(lds, c))) PH(18, (run_phase<1, 8>(lds, c)))
#undef PH
}


#ifdef PROBE_STOP
__global__ void probe_dump(const bf16_t* A, const bf16_t* B, int bmask, int bshift, const float* F, float* out) {
    for (size_t i = (size_t)blockIdx.x * 256 + threadIdx.x; i < (size_t)M_LAT * 1024; i += (size_t)gridDim.x * 256) {
        float v = 0.f;
        if (A) v += bflo((unsigned)A[i]);
        if (B) { const size_t row = i >> 10, col = i & 1023; v += bflo((unsigned)B[(row << bshift) + (col & bmask)]); }
        if (F) v += F[i & (((size_t)1 << 22) - 1)];
        out[i] = v;
    }
}
__global__ void probe_diff(const bf16_t* A, const bf16_t* B, float* out) {
    for (size_t i = (size_t)blockIdx.x * 256 + threadIdx.x; i < (size_t)M_LAT * 1024; i += (size_t)gridDim.x * 256) out[i] = 1.0e6f * (bflo((unsigned)A[i]) - bflo((unsigned)B[i]));
}
#endif
extern "C" void kernel_launch(void* const* d_in, const int* in_sizes, int n_in, void* d_out, int out_size, void* d_ws, size_t ws_size, hipStream_t stream) {
    static int grid = 0;
    if (grid == 0) {
        if (n_in != 21 || ws_size < WS_END) fprintf(stderr, "kernel_launch: unexpected n_in %d or ws_size %zu (need %zu)\n", n_in, ws_size, (size_t)WS_END);
        int dev = 0, cus = 0, per_cu = 0;
        hipGetDevice(&dev); hipDeviceGetAttribute(&cus, hipDeviceAttributeMultiprocessorCount, dev);
        if (hipFuncSetAttribute((const void*)fwd_mega, hipFuncAttributeMaxDynamicSharedMemorySize, LDS_BYTES) != hipSuccess) fprintf(stderr, "kernel_launch: hipFuncSetAttribute failed\n");
        if (hipOccupancyMaxActiveBlocksPerMultiprocessor(&per_cu, (const void*)fwd_mega, 512, LDS_BYTES) != hipSuccess || per_cu < 1) { fprintf(stderr, "kernel_launch: occupancy query says %d\n", per_cu); per_cu = 1; }
        (void)hipGetLastError();
        grid = cus * 1;
        if (grid <= 0) grid = 256;
    }
    hipMemsetAsync(d_ws, 0, CTL_ZERO_BYTES, stream);
#ifdef DBG_POISON
    hipMemsetAsync((char*)d_ws + CTL_ZERO_BYTES, 0xAA, WS_END - CTL_ZERO_BYTES, stream);
    hipMemsetAsync(d_out, 0xAA, (size_t)M_LAT * 1024 * 4, stream);
#endif
    Args a{};
    for (int i = 0; i < 21; ++i) a.in[i] = (const float*)d_in[i];
    a.out = (float*)d_out; a.ws = (unsigned char*)d_ws;
#if MK_COOP
    a.ph_lo = 0; a.ph_hi = N_PHASES;
    void* args[] = {&a};
    hipError_t e = hipLaunchCooperativeKernel((const void*)fwd_mega, dim3(grid), dim3(512), args, LDS_BYTES, stream);
    if (e != hipSuccess) fprintf(stderr, "kernel_launch: cooperative launch failed: %s (grid %d)\n", hipGetErrorString(e), grid);
#else
#if defined(PROBE_STOP) && PROBE_STOP == 21
    for (int ph = 0; ph < 9; ++ph) { a.ph_lo = ph; a.ph_hi = ph + 1; hipLaunchKernelGGL(fwd_mega, dim3(grid), dim3(512), LDS_BYTES, stream, a); }
    hipMemcpyAsync((char*)d_ws + WS_YT, (char*)d_ws + WS_Q, (size_t)64 * MiB, hipMemcpyDeviceToDevice, stream);
    a.ph_lo = 8; a.ph_hi = 9; hipLaunchKernelGGL(fwd_mega, dim3(grid), dim3(512), LDS_BYTES, stream, a);
    hipLaunchKernelGGL(probe_diff, dim3(2048), dim3(256), 0, stream, (const bf16_t*)((char*)d_ws + WS_Q), (const bf16_t*)((char*)d_ws + WS_YT), (float*)d_out);
#elif defined(PROBE_STOP) && PROBE_STOP >= 100
    for (int ph = 0; ph < PROBE_STOP - 100; ++ph) { a.ph_lo = ph; a.ph_hi = ph + 1; hipLaunchKernelGGL(fwd_mega, dim3(grid), dim3(512), LDS_BYTES, stream, a); }
    hipMemcpyAsync((char*)d_ws + WS_YT, (char*)d_ws + (size_t)PROBE_BUF * MiB, (size_t)64 * MiB, hipMemcpyDeviceToDevice, stream);
    hipMemsetAsync(d_ws, 0, CTL_ZERO_BYTES, stream);
    for (int ph = 0; ph < PROBE_STOP - 100; ++ph) { a.ph_lo = ph; a.ph_hi = ph + 1; hipLaunchKernelGGL(fwd_mega, dim3(grid), dim3(512), LDS_BYTES, stream, a); }
    hipLaunchKernelGGL(probe_diff, dim3(2048), dim3(256), 0, stream, (const bf16_t*)((char*)d_ws + (size_t)PROBE_BUF * MiB), (const bf16_t*)((char*)d_ws + WS_YT), (float*)d_out);
#elif defined(PROBE_STOP)
    for (int ph = 0; ph < (PROBE_STOP == 20 ? 10 : PROBE_STOP); ++ph) { a.ph_lo = ph; a.ph_hi = ph + 1; hipLaunchKernelGGL(fwd_mega, dim3(grid), dim3(512), LDS_BYTES, stream, a); }
    { unsigned char* w = (unsigned char*)d_ws; const bf16_t* A = nullptr; const bf16_t* B = nullptr; const float* F = nullptr; int bmask = 1023, bshift = 10;
      if (PROBE_STOP == 1) { A = (const bf16_t*)(w + WS_W + W_F); B = (const bf16_t*)(w + WS_DFT); bmask = 1023; bshift = 12; F = (const float*)(w + OFF_MOD); }
      if (PROBE_STOP == 2) { A = (const bf16_t*)(w + WS_H); }
      if (PROBE_STOP == 3) { A = (const bf16_t*)(w + WS_K); B = (const bf16_t*)(w + WS_Q); }
      if (PROBE_STOP == 4) { A = (const bf16_t*)(w + WS_Q); B = (const bf16_t*)(w + WS_FM); bmask = 511; bshift = 9; }
      if (PROBE_STOP == 5) { A = (const bf16_t*)(w + WS_K); }
      if (PROBE_STOP == 6) { A = (const bf16_t*)(w + WS_H); }
      if (PROBE_STOP == 8) { A = (const bf16_t*)(w + WS_H); }
      if (PROBE_STOP == 9) { A = (const bf16_t*)(w + WS_Q); }
      if (PROBE_STOP == 11 || PROBE_STOP == 17) { A = (const bf16_t*)(w + WS_H); }
      if (PROBE_STOP == 20) { F = (const float*)(w + WS_RC); }
      if (PROBE_STOP == 12) { A = (const bf16_t*)(w + WS_K); B = (const bf16_t*)(w + WS_Q); }
      if (PROBE_STOP == 13) { A = (const bf16_t*)(w + WS_Q); B = (const bf16_t*)(w + WS_FM); bmask = 511; bshift = 9; }
      if (PROBE_STOP == 14) { A = (const bf16_t*)(w + WS_K); }
      if (PROBE_STOP == 15) { A = (const bf16_t*)(w + WS_H); }
      if (PROBE_STOP == 18) { A = (const bf16_t*)(w + WS_Q); }
      if (PROBE_STOP == 7 || PROBE_STOP == 10 || PROBE_STOP == 16) { }
      else hipLaunchKernelGGL(probe_dump, dim3(2048), dim3(256), 0, stream, A, B, bmask, bshift, F, (float*)d_out); }
#else
    for (int ph = 0; ph < N_PHASES; ++ph) { a.ph_lo = ph; a.ph_hi = ph + 1; hipLaunchKernelGGL(fwd_mega, dim3(grid), dim3(512), LDS_BYTES, stream, a); }
#endif
#endif
}
```

```cpp
#define MK_SP2 true
#define MK_ALIGN true
#include <hip/hip_runtime.h>
#include <hip/hip_cooperative_groups.h>
#include <hip/hip_bf16.h>
#include <cstdio>
#include <cstdint>
namespace cg = cooperative_groups;
#ifndef MK_COOP
#define MK_COOP 1
#endif
__device__ __forceinline__ int mk_lane() { return (int)__builtin_amdgcn_mbcnt_hi(~0u, __builtin_amdgcn_mbcnt_lo(~0u, 0u)) & 63; }
namespace pg8 {
#define PG8_LAS __attribute__((address_space(3)))
typedef unsigned short bf16_t;
typedef short bf16x8 __attribute__((ext_vector_type(8)));
typedef float f32x4 __attribute__((ext_vector_type(4)));
typedef unsigned u32x4 __attribute__((ext_vector_type(4)));
constexpr int BM = 256, BK = 64, HALF = 128, HTB = HALF * BK * 2  , STAGE_BYTES = 8 * HTB, NXCD = 8, WGM = 8;

__host__ __device__ __forceinline__ int lds_byte(int r, int c) { const int st = (r >> 4) * 2 + (c >> 5), rr = r & 15, cc = c & 31, ob = rr * 64 + cc * 2; return st * 1024 + (ob ^ (((ob >> 9) & 1) << 5)); }
__host__ __device__ __forceinline__ void stage_rc(int b, int& R, int& C) { const int st = b / 1024, sb = b % 1024, swz = sb ^ (((sb >> 9) & 1) << 5); R = (st >> 1) * 16 + swz / 64; C = (st & 1) * 32 + (swz % 64) / 2; }
__host__ __device__ __forceinline__ int perm32(int rho) { const int n = rho >> 4, i = rho & 15; return 8 * (i >> 2) + 4 * n + (i & 3); }

struct Unit { int pm, pn; };
struct Gemm { const bf16_t* A; const bf16_t* Bt; int M, N, K; int ld; };

struct StaticOrder {
    int nM, nN, nwg, G, c;
    __host__ __device__ void init(int M, int N, int G_, int c_) { nM = M / BM; nN = N / BM; nwg = nM * nN; G = G_; c = c_; }
    __host__ __device__ bool next(int i, Unit& u) const {
        const long L = (long)i * G + c; if (L >= nwg) return false;
        int wgid = (int)L; { const int q = nwg / NXCD, r = nwg % NXCD, xcd = wgid % NXCD, off = wgid / NXCD; wgid = (xcd < r ? xcd * (q + 1) : r * (q + 1) + (xcd - r) * q) + off; }
        const int nig = WGM * nN, gid = wgid / nig, fm = gid * WGM, gsz = (nM - fm) < WGM ? (nM - fm) : WGM;
        u.pm = fm + ((wgid % nig) % gsz); u.pn = (wgid % nig) / gsz; return true;
    }
    __device__ __forceinline__ void a_ready(const Unit&) const {}
    __device__ __forceinline__ void done(const Unit&) const {}
};
__device__ __forceinline__ unsigned cvt_pk_bf16(float lo, float hi) { unsigned r; asm volatile("v_cvt_pk_bf16_f32 %0, %1, %2" : "=v"(r) : "v"(lo), "v"(hi)); return r; }
typedef float f32x2 __attribute__((ext_vector_type(2)));
template <class Epi, class Sched, bool ALIGN_EPI = false, bool SP2 = false, int BMODE = 0>
__device__ __forceinline__ void gemm_phase(PG8_LAS unsigned char* lds, const Gemm g, const Sched& S, const Epi& E, const int wave_s_) {
    int tid_ = threadIdx.x; asm volatile("" : "+v"(tid_));
    const int tid = tid_, wid = __builtin_amdgcn_readfirstlane(tid >> 6), lane = tid & 63, wr = wid >> 2, wc = wid & 3, fr = lane & 15, fq = lane >> 4;
    const int K = g.K, nt = K / BK, LD = g.ld ? g.ld : g.K;
    unsigned voffA[2], voffB[2]; int voffBh[2];
#pragma unroll
    for (int i = 0; i < 2; ++i) { int R, C; stage_rc(tid * 16 + i * 8192, R, C); const int Rb = Epi::PERM ? ((R & ~31) + perm32(R & 31)) : R;
        voffA[i] = (unsigned)(R * LD + C) * 2u; voffB[i] = (unsigned)(Rb * LD + C) * 2u; voffBh[i] = BMODE ? (C - Rb * LD) * 2 : (int)voffB[i]; }
    const size_t kstep = (size_t)(BK * 2);
    const size_t hstep = (size_t)HALF * LD * 2;
    const size_t tstep = 2 * hstep;
#define PG8_B0(pn_) (BMODE ? (const char*)g.Bt + (size_t)(((pn_) >> 3) * 2048 + ((pn_) & 7) * 128) * K * 2 : (const char*)g.Bt + (size_t)(pn_) * tstep)
#define PG8_B1(pn_, b0_) (BMODE ? (const char*)g.Bt + (size_t)(((pn_) >> 3) * 2048 + 2048 - ((pn_) & 7) * 128) * K * 2 : (b0_) + hstep)
    const unsigned ldsw = (unsigned)wid * 1024u;
    const int aoff = lds_byte(wr * 64 + fr, fq * 8), boff = lds_byte(wc * 32 + fr, fq * 8);
#define PG8_SA(b, h) (((b) * 2 + (h)) * HTB)
#define PG8_SB(b, h) ((4 + (b) * 2 + (h)) * HTB)
#define PG8_STAGE(bufoff, gbase, voff) do { _Pragma("unroll") for (int _i = 0; _i < 2; ++_i) \
        __builtin_amdgcn_global_load_lds((const unsigned*)((const char*)(gbase) + (voff)[_i]), (PG8_LAS unsigned*)(lds + (bufoff) + ldsw + _i * 8192), 16, 0, 0); } while (0)
#define PG8_LDA(dst, b, h) do { _Pragma("unroll") for (int m = 0; m < 4; ++m) _Pragma("unroll") for (int k = 0; k < 2; ++k) dst[m][k] = *(const PG8_LAS bf16x8*)(lds + PG8_SA(b, h) + aoff + m * 2048 + k * 1024); } while (0)
#define PG8_LDB(dst, b, h) do { _Pragma("unroll") for (int n = 0; n < 2; ++n) _Pragma("unroll") for (int k = 0; k < 2; ++k) dst[n][k] = *(const PG8_LAS bf16x8*)(lds + PG8_SB(b, h) + boff + n * 2048 + k * 1024); } while (0)
#define PG8_MMA(ai, bj, At, Bt) do { __builtin_amdgcn_s_setprio(1); _Pragma("unroll") for (int m = 0; m < 4; ++m) _Pragma("unroll") for (int n = 0; n < 2; ++n) _Pragma("unroll") for (int k = 0; k < 2; ++k) \
        acc[ai][bj][m][n] = __builtin_amdgcn_mfma_f32_16x16x32_bf16(Bt[n][k], At[m][k], acc[ai][bj][m][n], 0, 0, 0); __builtin_amdgcn_s_setprio(0); } while (0)
#define PG8_WAIT_V(n) asm volatile("s_waitcnt vmcnt(" #n ")" ::: "memory")
#define PG8_WAIT_L(n) asm volatile("s_waitcnt lgkmcnt(" #n ")" ::: "memory")
#define PG8_BAR __builtin_amdgcn_s_barrier()
#define PG8_SCHED __builtin_amdgcn_sched_barrier(0)
    Unit cur, nxt; int ui = 0;
    if (!S.next(0, cur)) return;
    f32x4 acc[2][2][4][2];
#pragma unroll
    for (int a = 0; a < 2; ++a)
#pragma unroll
        for (int b = 0; b < 2; ++b)
#pragma unroll
            for (int m = 0; m < 4; ++m)
#pragma unroll
                for (int n = 0; n < 2; ++n) acc[a][b][m][n] = (f32x4){0.f, 0.f, 0.f, 0.f};
    bf16x8 At[4][2], B0[2][2], B1[2][2];
    const char* cA = (const char*)g.A + (size_t)cur.pm * tstep; const char* cB = PG8_B0(cur.pn); const char* cBh = PG8_B1(cur.pn, cB);
    S.a_ready(cur);
    if constexpr (SP2) {
        PG8_STAGE(PG8_SB(0, 0), cB, voffB); PG8_STAGE(PG8_SB(0, 1), cBh, voffBh); PG8_STAGE(PG8_SA(0, 0), cA, voffA); PG8_STAGE(PG8_SA(0, 1), cA + hstep, voffA);
        if (wr == 1) PG8_BAR;
        PG8_WAIT_V(2); PG8_BAR;
        PG8_STAGE(PG8_SB(1, 0), cB + kstep, voffB); PG8_STAGE(PG8_SA(1, 0), cA + kstep, voffA); PG8_STAGE(PG8_SB(1, 1), cBh + kstep, voffBh);
        PG8_WAIT_V(6); PG8_BAR;
    } else {
        PG8_STAGE(PG8_SB(0, 0), cB, voffB); PG8_STAGE(PG8_SA(0, 0), cA, voffA); PG8_STAGE(PG8_SB(0, 1), cBh, voffBh); PG8_STAGE(PG8_SA(0, 1), cA + hstep, voffA);
        if (wr == 1) PG8_BAR;
        PG8_WAIT_V(4); PG8_BAR;
        PG8_STAGE(PG8_SB(1, 0), cB + kstep, voffB); PG8_STAGE(PG8_SA(1, 0), cA + kstep, voffA); PG8_STAGE(PG8_SB(1, 1), cBh + kstep, voffBh);
        PG8_WAIT_V(6); PG8_BAR;
    }
    for (;;) {
        const bool has_next = S.next(ui + 1, nxt);
        const char* nA = has_next ? (const char*)g.A + (size_t)nxt.pm * tstep : cA; const char* nB = has_next ? PG8_B0(nxt.pn) : cB; const char* nBh = has_next ? PG8_B1(nxt.pn, nB) : cBh;
        for (int t = 0; t < nt; t += 2) {
            const bool last = (t == nt - 2);
            const char* a1 = cA + (size_t)(t + 1) * kstep;
            const char* a2 = last ? nA : cA + (size_t)(t + 2) * kstep; const char* b2 = last ? nB : cB + (size_t)(t + 2) * kstep;
            const char* a3 = a2 + kstep; const char* b3 = b2 + kstep; const char* b2h = last ? nBh : cBh + (size_t)(t + 2) * kstep; const char* b3h = b2h + kstep;
            if (last && has_next) S.a_ready(nxt);
            if constexpr (SP2) {
            PG8_LDB(B0, 0, 0); PG8_LDB(B1, 0, 1); PG8_SCHED; PG8_LDA(At, 0, 0); PG8_STAGE(PG8_SA(1, 1), a1 + hstep, voffA);
            PG8_WAIT_V(8); PG8_WAIT_L(0); PG8_BAR; PG8_MMA(0, 0, At, B0); PG8_MMA(0, 1, At, B1); PG8_BAR; PG8_SCHED;
            PG8_LDA(At, 0, 1); PG8_STAGE(PG8_SB(0, 0), b2, voffB); PG8_STAGE(PG8_SB(0, 1), b2h, voffBh); PG8_STAGE(PG8_SA(0, 0), a2, voffA);
            PG8_WAIT_V(8); PG8_WAIT_L(0); PG8_BAR; PG8_MMA(1, 0, At, B0); PG8_MMA(1, 1, At, B1); PG8_BAR; PG8_SCHED;
            PG8_LDB(B0, 1, 0); PG8_LDB(B1, 1, 1); PG8_SCHED; PG8_LDA(At, 1, 0); PG8_STAGE(PG8_SA(0, 1), a2 + hstep, voffA);
            PG8_WAIT_V(8); PG8_WAIT_L(0); PG8_BAR; PG8_MMA(0, 0, At, B0); PG8_MMA(0, 1, At, B1); PG8_BAR; PG8_SCHED;
            PG8_LDA(At, 1, 1); PG8_STAGE(PG8_SB(1, 0), b3, voffB); PG8_STAGE(PG8_SB(1, 1), b3h, voffBh); PG8_STAGE(PG8_SA(1, 0), a3, voffA);
            PG8_WAIT_V(8); PG8_WAIT_L(0); PG8_BAR; PG8_MMA(1, 0, At, B0); PG8_MMA(1, 1, At, B1); PG8_BAR; PG8_SCHED;
            } else {
            PG8_LDB(B0, 0, 0); PG8_SCHED; PG8_LDA(At, 0, 0); PG8_STAGE(PG8_SA(1, 1), a1 + hstep, voffA);
            PG8_WAIT_L(8); PG8_BAR; PG8_WAIT_L(0); PG8_MMA(0, 0, At, B0); PG8_BAR; PG8_SCHED;
            PG8_LDB(B1, 0, 1); PG8_STAGE(PG8_SB(0, 0), b2, voffB);
            PG8_BAR; PG8_WAIT_L(0); PG8_MMA(0, 1, At, B1); PG8_BAR;
            PG8_LDA(At, 0, 1); PG8_STAGE(PG8_SA(0, 0), a2, voffA);
            PG8_BAR; PG8_WAIT_L(0); PG8_MMA(1, 0, At, B0); PG8_BAR; PG8_SCHED;
            PG8_STAGE(PG8_SB(0, 1), b2h, voffBh);
            PG8_WAIT_V(6); PG8_BAR; PG8_MMA(1, 1, At, B1); PG8_BAR;
            PG8_LDB(B0, 1, 0); PG8_SCHED; PG8_LDA(At, 1, 0); PG8_STAGE(PG8_SA(0, 1), a2 + hstep, voffA);
            PG8_WAIT_L(8); PG8_BAR; PG8_WAIT_L(0); PG8_MMA(0, 0, At, B0); PG8_BAR; PG8_SCHED;
            PG8_LDB(B1, 1, 1); PG8_STAGE(PG8_SB(1, 0), b3, voffB);
            PG8_BAR; PG8_WAIT_L(0); PG8_MMA(0, 1, At, B1); PG8_BAR;
            PG8_LDA(At, 1, 1); PG8_STAGE(PG8_SA(1, 0), a3, voffA);
            PG8_BAR; PG8_WAIT_L(0); PG8_MMA(1, 0, At, B0); PG8_BAR; PG8_SCHED;
            PG8_STAGE(PG8_SB(1, 1), b3h, voffBh);
            PG8_WAIT_V(6); PG8_BAR; PG8_MMA(1, 1, At, B1); PG8_BAR;
            }
        }
        if constexpr (ALIGN_EPI) { if (wr == 0) PG8_BAR; }
        if constexpr (!Epi::AFTER_DRAIN) { E(acc, cur, wr, wc, fr, fq); S.done(cur); }
        if (!has_next) break;
#pragma unroll
        for (int a = 0; a < 2; ++a)
#pragma unroll
            for (int b = 0; b < 2; ++b)
#pragma unroll
                for (int m = 0; m < 4; ++m)
#pragma unroll
                    for (int n = 0; n < 2; ++n) acc[a][b][m][n] = (f32x4){0.f, 0.f, 0.f, 0.f};
        cur = nxt; cA = nA; cB = nB; cBh = nBh; ++ui;
        if constexpr (ALIGN_EPI) { if (wr == 1) PG8_BAR; }
    }
    PG8_WAIT_V(0);
    if constexpr (!ALIGN_EPI) { if (wr == 0) PG8_BAR; }
    PG8_BAR;
    if constexpr (Epi::AFTER_DRAIN) { E.fused(acc, cur, wr, wc, fr, fq, lds, wid, lane); S.done(cur); }
#undef PG8_SA
#undef PG8_SB
#undef PG8_STAGE
#undef PG8_LDA
#undef PG8_LDB
#undef PG8_MMA
#undef PG8_WAIT_V
#undef PG8_WAIT_L
#undef PG8_BAR
#undef PG8_SCHED
}
}

constexpr int DM = 1024, NB = 16, SEQ = 2048, CTXL = 256;
constexpr int M_LAT = NB * SEQ, M_CTX = NB * CTXL, M_ALL = M_LAT + M_CTX;
constexpr int DFF = 2816, INW = 5632;
constexpr float EPS = 1e-6f;
constexpr float LOG2E = 1.4426950408889634f;
constexpr float QSCALE = 0.125f * LOG2E;
typedef unsigned short bf16_t;
typedef unsigned u32x4 __attribute__((ext_vector_type(4)));
typedef unsigned u32x2 __attribute__((ext_vector_type(2)));
typedef float f32x4 __attribute__((ext_vector_type(4)));
#define LAS __attribute__((address_space(3)))

constexpr size_t MiB = 1u << 20;
constexpr size_t OFF_LAM = 0, OFF_ROPE = 4096, OFF_XBAR = 16384, OFF_MOD = 65536, CTL_ZERO_BYTES = 1 * MiB;
constexpr size_t WS_W = 1 * MiB, W_LSTRIDE = 34 * MiB;
constexpr size_t W_KVQ = 0, W_G = 6 * MiB, W_F = 10 * MiB, W_PA = 12 * MiB, W_PF = 14 * MiB, W_OUT = 15 * MiB, W_GU = 17 * MiB, W_D = 28 * MiB;
constexpr size_t WS_DFT = 69 * MiB, WS_DFTC = 85 * MiB, WS_RC = 86 * MiB, WS_H = 102 * MiB, WS_Q = 174 * MiB, WS_K = 246 * MiB, WS_V = 318 * MiB;
constexpr size_t WS_YT = 390 * MiB, WS_YTC = 454 * MiB, WS_FM = 462 * MiB, WS_END = 498 * MiB;
constexpr int LDS_BYTES = 147456;
constexpr size_t WS_WFC = WS_DFT + 9 * MiB;
constexpr int ZK = 2176;

typedef float f32x2_t __attribute__((ext_vector_type(2))); typedef __bf16 bf16x2_t __attribute__((ext_vector_type(2)));
__device__ __forceinline__ unsigned pk2(float lo, float hi) { f32x2_t v = {lo, hi}; bf16x2_t b = __builtin_convertvector(v, bf16x2_t); return __builtin_bit_cast(unsigned, b); }
__device__ __forceinline__ float bflo(unsigned w) { return __uint_as_float(w << 16); }
__device__ __forceinline__ float bfhi(unsigned w) { return __uint_as_float(w & 0xffff0000u); }
__device__ __forceinline__ unsigned f2bf(float f) { unsigned u = __float_as_uint(f); return (u + 0x7fffu + ((u >> 16) & 1u)) >> 16; }
__device__ __forceinline__ float fast_exp2(float x) { return __builtin_amdgcn_exp2f(x); }
__device__ __forceinline__ float fast_rcp(float x) { return __builtin_amdgcn_rcpf(x); }
__device__ __forceinline__ float sigmoidf_(float x) { return fast_rcp(1.f + fast_exp2(-x * LOG2E)); }
__device__ __forceinline__ float wave_sum(float v) {
#pragma unroll
    for (int o = 1; o < 64; o <<= 1) v += __shfl_xor(v, o);
    return v;
}

namespace ep {
using pg8::Unit; using pg8::BM; using pg8::HALF;
struct EpiKVQ {
    static constexpr bool PERM = false, AFTER_DRAIN = false;
    bf16_t *Kb, *Vb, *Qb; const LAS float* tab;
    __device__ __forceinline__ void operator()(const f32x4 (&acc)[2][2][4][2], const Unit& u, int wr, int wc, int fr, int fq) const {
        const int sect = u.pn >> 2, pt = u.pn & 3;
        const int row0 = u.pm * BM + wr * 64 + fr;
        if (sect == 1) {
#pragma unroll
            for (int ai = 0; ai < 2; ++ai)
#pragma unroll
                for (int m = 0; m < 4; ++m) { bf16_t* rowp = Vb + (size_t)(row0 + ai * HALF + m * 16) * 1024 + pt * 256 + wc * 32 + 8 * fq;
#pragma unroll
                    for (int bj = 0; bj < 2; ++bj) { const f32x4 v0 = acc[ai][bj][m][0], v1 = acc[ai][bj][m][1];
                        u32x4 w; w.x = pk2(v0[0], v0[1]); w.y = pk2(v0[2], v0[3]); w.z = pk2(v1[0], v1[1]); w.w = pk2(v1[2], v1[3]);
                        *(u32x4*)(rowp + bj * HALF) = w; } }
        } else {
            const LAS float* g = tab + (sect == 0 ? 2048 : 2112); const LAS float* rope = tab; const float osc = sect == 0 ? 1.f : QSCALE; bf16_t* dst = sect == 0 ? Kb : Qb;
            const bool isctx = u.pm >= 128;
#pragma unroll
            for (int ai = 0; ai < 2; ++ai)
#pragma unroll
                for (int m = 0; m < 4; ++m) {
                    const int row = row0 + ai * HALF + m * 16;
                    float ss = 0.f;
#pragma unroll
                    for (int bj = 0; bj < 2; ++bj)
#pragma unroll
                        for (int n = 0; n < 2; ++n) { const f32x4 x = acc[ai][bj][m][n]; ss += (x[0] * x[0] + x[1] * x[1]) + (x[2] * x[2] + x[3] * x[3]); }
                    ss += __shfl_xor(ss, 16); ss += __shfl_xor(ss, 32);
                    const float rinv = rsqrtf(ss * (1.f / 64.f) + EPS) * osc;
                    const int t = row & 2047; const int pos0 = t >> 6, pos1 = t & 63;
                    bf16_t* p = dst + (size_t)row * 1024 + (pt * 4 + wc) * 64 + 16 * fq;
#pragma unroll
                    for (int bj = 0; bj < 2; ++bj) {
                        const f32x4 g0 = *(const LAS f32x4*)(g + 32 * bj + 4 * fq), g1 = *(const LAS f32x4*)(g + 32 * bj + 16 + 4 * fq);
                        f32x4 x1 = acc[ai][bj][m][0] * (g0 * rinv), x2 = acc[ai][bj][m][1] * (g1 * rinv);
                        asm volatile("" : "+v"(x1), "+v"(x2) :: "memory");
#ifndef NO_ROPE
                        if (!isctx) { const int pos = bj == 0 ? pos0 : pos1;
                            const f32x4 c = *(const LAS f32x4*)(rope + pos * 16 + 4 * fq), s = *(const LAS f32x4*)(rope + 1024 + pos * 16 + 4 * fq);
                            const f32x4 y1 = x1 * c - x2 * s, y2 = x2 * c + x1 * s; x1 = y1; x2 = y2; }
#endif
                        u32x4 w; w.x = pk2(x1[0], x1[1]); w.y = pk2(x1[2], x1[3]); w.z = pk2(x2[0], x2[1]); w.w = pk2(x2[2], x2[3]);
                        *(u32x4*)(p + 8 * bj) = w;
                        asm volatile("" ::: "memory");
                    }
                }
        }
    }
};
struct EpiYT {
    static constexpr bool PERM = true, AFTER_DRAIN = false;
    bf16_t *YT, *YTC;
    __device__ __forceinline__ void operator()(const f32x4 (&acc)[2][2][4][2], const Unit& u, int wr, int wc, int fr, int fq) const {
        const bool isctx = u.pn >= 128;
        bf16_t* base = isctx ? YTC + (size_t)(u.pn - 128) * 1024 * 256 : YT + (size_t)(u.pn >> 3) * 1024 * 2048 + (u.pn & 7) * 256;
        const int rs = isctx ? 256 : 2048;
        const int r0 = u.pm * BM + wr * 64 + fr;
#pragma unroll
        for (int ai = 0; ai < 2; ++ai)
#pragma unroll
            for (int m = 0; m < 4; ++m) { bf16_t* rowp = base + (size_t)(r0 + ai * HALF + m * 16) * rs + wc * 32 + 8 * fq;
#pragma unroll
                for (int bj = 0; bj < 2; ++bj) { const f32x4 v0 = acc[ai][bj][m][0], v1 = acc[ai][bj][m][1];
                    u32x4 w; w.x = pk2(v0[0], v0[1]); w.y = pk2(v0[2], v0[3]); w.z = pk2(v1[0], v1[1]); w.w = pk2(v1[2], v1[3]);
                    *(u32x4*)(rowp + bj * HALF) = w; } }
    }
};
struct EpiYTm {
    static constexpr bool PERM = true, AFTER_DRAIN = false;
    bf16_t* Z;
    __device__ __forceinline__ void operator()(const f32x4 (&acc)[2][2][4][2], const Unit& u, int wr, int wc, int fr, int fq) const {
        const int t0 = (u.pn & 7) * 128 + wc * 32 + 8 * fq, cs = fr & 1;
        const int r0 = u.pm * BM + wr * 64 + fr;
        bf16_t* zb = Z + (size_t)((u.pn >> 3) * 512) * ZK + t0;
#pragma unroll
        for (int ai = 0; ai < 2; ++ai)
#pragma unroll
            for (int m = 0; m < 4; ++m) { const int q = (r0 + ai * HALF + m * 16) >> 1, g = q >> 6, cp = q & 63;
                const bool c64 = (cp == 0) && cs;
                const bool costype = !cs || c64;
                const float sgn = costype ? 1.f : -1.f;
                f32x4 za = acc[ai][0][m][0] + acc[ai][1][m][0] * sgn, zc = acc[ai][0][m][1] + acc[ai][1][m][1] * sgn;
                if (t0 == 0 && costype) za[0] = acc[ai][0][m][0][0];
                u32x4 w; w.x = pk2(za[0], za[1]); w.y = pk2(za[2], za[3]); w.z = pk2(zc[0], zc[1]); w.w = pk2(zc[2], zc[3]);
                const int n1 = g * 128 + (cp ? cp : (c64 ? 64 : 0)), p1 = cp ? cs * 1024 : 0;
                const int n2 = cp ? g * 128 + 128 - cp : n1, p2 = cp ? p1 : 1024;
                const unsigned flip = (cp && cs) ? 0x80008000u : 0u, keep = cp ? 0xffffffffu : 0u;
                *(u32x4*)(zb + n1 * ZK + p1) = w;
                asm volatile("" ::: "memory");
                w.x = (w.x ^ flip) & keep; w.y = (w.y ^ flip) & keep; w.z = (w.z ^ flip) & keep; w.w = (w.w ^ flip) & keep;
                *(u32x4*)(zb + n2 * ZK + p2) = w;
                asm volatile("" ::: "memory"); }
    }
};
struct EpiYTc {
    static constexpr bool PERM = true, AFTER_DRAIN = false;
    bf16_t* YTC;
    __device__ __forceinline__ void operator()(const f32x4 (&acc)[2][2][4][2], const Unit& u, int wr, int wc, int fr, int fq) const {
        bf16_t* base = YTC + (size_t)u.pn * 1024 * 256;
        const int r0 = u.pm * BM + wr * 64 + fr;
#pragma unroll
        for (int ai = 0; ai < 2; ++ai)
#pragma unroll
            for (int m = 0; m < 4; ++m) { bf16_t* rowp = base + (size_t)(r0 + ai * HALF + m * 16) * 256 + wc * 32 + 8 * fq;
#pragma unroll
                for (int bj = 0; bj < 2; ++bj) { const f32x4 v0 = acc[ai][bj][m][0], v1 = acc[ai][bj][m][1];
                    u32x4 w; w.x = pk2(v0[0], v0[1]); w.y = pk2(v0[2], v0[3]); w.z = pk2(v1[0], v1[1]); w.w = pk2(v1[2], v1[3]);
                    *(u32x4*)(rowp + bj * HALF) = w; } }
    }
};
struct EpiGate {
    static constexpr bool PERM = false, AFTER_DRAIN = false;
    bf16_t* G;
    __device__ __forceinline__ void operator()(const f32x4 (&acc)[2][2][4][2], const Unit& u, int wr, int wc, int fr, int fq) const {
        const int row0 = u.pm * BM + wr * 64 + fr;
#pragma unroll
        for (int ai = 0; ai < 2; ++ai)
#pragma unroll
            for (int m = 0; m < 4; ++m) { bf16_t* rowp = G + (size_t)(row0 + ai * HALF + m * 16) * 2048 + u.pn * 256 + wc * 32 + 8 * fq;
#pragma unroll
                for (int bj = 0; bj < 2; ++bj) { const f32x4 v0 = acc[ai][bj][m][0], v1 = acc[ai][bj][m][1];
                    u32x4 w; w.x = pk2(sigmoidf_(v0[0]), sigmoidf_(v0[1])); w.y = pk2(sigmoidf_(v0[2]), sigmoidf_(v0[3]));
                    w.z = pk2(sigmoidf_(v1[0]), sigmoidf_(v1[1])); w.w = pk2(sigmoidf_(v1[2]), sigmoidf_(v1[3]));
                    *(u32x4*)(rowp + bj * HALF) = w; } }
    }
};
template <bool ADD> struct EpiMerge {
    static constexpr bool PERM = false, AFTER_DRAIN = false;
    bf16_t* MG; const bf16_t* G; int goff;
    __device__ __forceinline__ void operator()(const f32x4 (&acc)[2][2][4][2], const Unit& u, int wr, int wc, int fr, int fq) const {
        const int row0 = u.pm * BM + wr * 64 + fr; const int col = u.pn * 256 + wc * 32 + 8 * fq;
        u32x4 gc[2], gn[2], oc[2], on[2];
#pragma unroll
        for (int bj = 0; bj < 2; ++bj) { gc[bj] = *(const u32x4*)(G + (size_t)row0 * 2048 + goff + col + bj * HALF); if (ADD) oc[bj] = *(const u32x4*)(MG + (size_t)row0 * 1024 + col + bj * HALF); }
#pragma unroll
        for (int it = 0; it < 8; ++it) { const int ai = it >> 2, m = it & 3; const int row = row0 + ai * HALF + m * 16;
            if (it < 7) { const int rown = row0 + ((it + 1) >> 2) * HALF + ((it + 1) & 3) * 16;
#pragma unroll
                for (int bj = 0; bj < 2; ++bj) { gn[bj] = *(const u32x4*)(G + (size_t)rown * 2048 + goff + col + bj * HALF); if (ADD) on[bj] = *(const u32x4*)(MG + (size_t)rown * 1024 + col + bj * HALF); } }
#pragma unroll
            for (int bj = 0; bj < 2; ++bj) { const f32x4 v0 = acc[ai][bj][m][0], v1 = acc[ai][bj][m][1]; const u32x4 g = gc[bj];
                bf16_t* mp = MG + (size_t)row * 1024 + col + bj * HALF;
                float r[8] = {v0[0] * bflo(g.x), v0[1] * bfhi(g.x), v0[2] * bflo(g.y), v0[3] * bfhi(g.y), v1[0] * bflo(g.z), v1[1] * bfhi(g.z), v1[2] * bflo(g.w), v1[3] * bfhi(g.w)};
                if (ADD) { const u32x4 o = oc[bj];
                    r[0] += bflo(o.x); r[1] += bfhi(o.x); r[2] += bflo(o.y); r[3] += bfhi(o.y); r[4] += bflo(o.z); r[5] += bfhi(o.z); r[6] += bflo(o.w); r[7] += bfhi(o.w); }
                u32x4 w; w.x = pk2(r[0], r[1]); w.y = pk2(r[2], r[3]); w.z = pk2(r[4], r[5]); w.w = pk2(r[6], r[7]);
                *(u32x4*)mp = w; gc[bj] = gn[bj]; if (ADD) oc[bj] = on[bj]; }
            asm volatile("" ::: "memory"); }
    }
};
struct EpiRes {
    static constexpr bool PERM = false, AFTER_DRAIN = false;
    const float *in_lat, *in_ctx; float *out_lat, *out_ctx; const float* gate; float gscale;
    __device__ __forceinline__ void operator()(const f32x4 (&acc)[2][2][4][2], const Unit& u, int wr, int wc, int fr, int fq) const {
        const bool isctx = u.pm >= 128; const int modrow = isctx ? 16 : (u.pm >> 3);
        const float* inb = isctx ? in_ctx - (size_t)M_LAT * 1024 : in_lat; float* outb = isctx ? out_ctx - (size_t)M_LAT * 1024 : out_lat;
        const int col = u.pn * 256 + wc * 32 + 8 * fq; const int row0 = u.pm * BM + wr * 64 + fr;
        f32x4 gv[2][2];
#pragma unroll
        for (int bj = 0; bj < 2; ++bj)
#pragma unroll
            for (int n = 0; n < 2; ++n) gv[bj][n] = *(const f32x4*)(gate + (size_t)modrow * 6144 + col + bj * HALF + 4 * n) * gscale;
        f32x4 cur[2][2], nxt[2][2];
#pragma unroll
        for (int bj = 0; bj < 2; ++bj)
#pragma unroll
            for (int n = 0; n < 2; ++n) cur[bj][n] = *(const f32x4*)(inb + (size_t)row0 * 1024 + col + bj * HALF + 4 * n);
#pragma unroll
        for (int it = 0; it < 8; ++it) { const int ai = it >> 2, m = it & 3; const size_t off = (size_t)(row0 + ai * HALF + m * 16) * 1024 + col;
            if (it < 7) { const size_t offn = (size_t)(row0 + ((it + 1) >> 2) * HALF + ((it + 1) & 3) * 16) * 1024 + col;
#pragma unroll
                for (int bj = 0; bj < 2; ++bj)
#pragma unroll
                    for (int n = 0; n < 2; ++n) nxt[bj][n] = *(const f32x4*)(inb + offn + bj * HALF + 4 * n); }
#pragma unroll
            for (int bj = 0; bj < 2; ++bj)
#pragma unroll
                for (int n = 0; n < 2; ++n) { *(f32x4*)(outb + off + bj * HALF + 4 * n) = cur[bj][n] + gv[bj][n] * acc[ai][bj][m][n]; cur[bj][n] = nxt[bj][n]; }
            asm volatile("" ::: "memory"); }
    }
};
struct EpiPart {
    static constexpr bool PERM = false, AFTER_DRAIN = false;
    float* P;
    __device__ __forceinline__ void operator()(const f32x4 (&acc)[2][2][4][2], const Unit& u, int wr, int wc, int fr, int fq) const {
        const int col = u.pn * 256 + wc * 32 + 8 * fq; const int row0 = u.pm * BM + wr * 64 + fr;
#pragma unroll
        for (int ai = 0; ai < 2; ++ai)
#pragma unroll
            for (int m = 0; m < 4; ++m) { float* rp = P + (size_t)(row0 + ai * HALF + m * 16) * 1024 + col;
#pragma unroll
                for (int bj = 0; bj < 2; ++bj)
#pragma unroll
                    for (int n = 0; n < 2; ++n) *(f32x4*)(rp + bj * HALF + 4 * n) = acc[ai][bj][m][n]; }
    }
};
struct EpiGU {
    static constexpr bool PERM = false, AFTER_DRAIN = false;
    bf16_t* ACT;
    __device__ __forceinline__ void operator()(const f32x4 (&acc)[2][2][4][2], const Unit& u, int wr, int wc, int fr, int fq) const {
        const int row0 = u.pm * BM + wr * 64 + fr;
#pragma unroll
        for (int ai = 0; ai < 2; ++ai)
#pragma unroll
            for (int m = 0; m < 4; ++m) { bf16_t* rowp = ACT + (size_t)(row0 + ai * HALF + m * 16) * DFF + u.pn * 128 + wc * 32 + 8 * fq;
                float r[8];
#pragma unroll
                for (int n = 0; n < 2; ++n)
#pragma unroll
                    for (int e = 0; e < 4; ++e) { const float g = acc[ai][0][m][n][e], up = acc[ai][1][m][n][e]; r[4 * n + e] = g * sigmoidf_(g) * up; }
                u32x4 w; w.x = pk2(r[0], r[1]); w.y = pk2(r[2], r[3]); w.z = pk2(r[4], r[5]); w.w = pk2(r[6], r[7]);
                *(u32x4*)rowp = w; }
    }
};
struct EpiFM {
    static constexpr bool PERM = true, AFTER_DRAIN = false;
    bf16_t* FM; int rowbase0, rpb;
    __device__ __forceinline__ void operator()(const f32x4 (&acc)[2][2][4][2], const Unit& u, int wr, int wc, int fr, int fq) const {
        const int b = u.pn >> 1; const int ncol = (u.pn & 1) * 256 + wc * 32 + 8 * fq;
        const int r0 = rowbase0 + b * rpb + u.pm * BM + wr * 64 + fr;
#pragma unroll
        for (int ai = 0; ai < 2; ++ai)
#pragma unroll
            for (int m = 0; m < 4; ++m) { bf16_t* rowp = FM + (size_t)(r0 + ai * HALF + m * 16) * 512 + ncol;
#pragma unroll
                for (int bj = 0; bj < 2; ++bj) { const f32x4 v0 = acc[ai][bj][m][0], v1 = acc[ai][bj][m][1];
                    u32x4 w; w.x = pk2(v0[0], v0[1]); w.y = pk2(v0[2], v0[3]); w.z = pk2(v1[0], v1[1]); w.w = pk2(v1[2], v1[3]);
                    *(u32x4*)(rowp + bj * HALF) = w; } }
    }
};
}

#define XB_TMO      128
#define XB_XCNT(j)  (256  + 64 * (j))
#define XB_XSUB(j)  (1280 + 64 * (j))
#define XB_XGEN(j)  (2304 + 64 * (j))
#define XB_TOP      3328
#define XB_TOPGEN   3392
#define XCD_BAR_WORDS 3456
#define XB_SPIN_CAP (1u << 18)

__device__ __forceinline__ unsigned xb_ld(unsigned* p)              { return __hip_atomic_load(p, __ATOMIC_RELAXED, __HIP_MEMORY_SCOPE_AGENT); }
__device__ __forceinline__ unsigned xb_add(unsigned* p, unsigned v) { return __hip_atomic_fetch_add(p, v, __ATOMIC_RELAXED, __HIP_MEMORY_SCOPE_AGENT); }
__device__ __forceinline__ unsigned xb_xcc_id() { return (unsigned)__builtin_amdgcn_s_getreg((3 << 11) | 20) & 0xFu; }
#define XB_SPIN(cond, bar) do { unsigned _sp = 0; while (cond) { __builtin_amdgcn_s_sleep(1); \
    if ((++_sp & 255u) == 0u) { if (xb_ld(&(bar)[XB_TMO])) break; if (_sp > XB_SPIN_CAP) { atomicAdd(&(bar)[XB_TMO], 1u); break; } } } } while (0)

struct XcdBarrier {
    unsigned* bar; unsigned x;
    volatile LAS unsigned* st;
};

__device__ __forceinline__ XcdBarrier xcd_barrier_post(unsigned* bar, volatile LAS unsigned* st) {
    XcdBarrier b; b.bar = bar; b.x = xb_xcc_id(); b.st = st;
    if (threadIdx.x == 0) (void)xb_add(&bar[XB_XCNT(b.x)], 1u);
    return b;
}
__device__ __forceinline__ void xcd_barrier_complete(unsigned* bar, unsigned x, unsigned& nloc, unsigned& nx) {
    const unsigned G = gridDim.x * gridDim.y * gridDim.z;
    unsigned sum, cnt, mine, sp = 0u;
    for (;;) {
        sum = 0u; cnt = 0u; mine = 0u;
#pragma unroll
        for (unsigned j = 0; j < 16; ++j) { const unsigned c = xb_ld(&bar[XB_XCNT(j)]); sum += c; cnt += (c > 0u) ? 1u : 0u; mine = (j == x) ? c : mine; }
        if (sum == G) break;
        __builtin_amdgcn_s_sleep(1);
        if ((++sp & 255u) == 0u) { if (xb_ld(&bar[XB_TMO])) break; if (sp > XB_SPIN_CAP) { atomicAdd(&bar[XB_TMO], 1u); break; } }
    }
    nloc = mine > 0u ? mine : 1u; nx = cnt > 0u ? cnt : 1u;
}

__device__ __forceinline__ void xcd_barrier(const XcdBarrier& b) {
    asm volatile("s_waitcnt vmcnt(0)" ::: "memory");
    __syncthreads();
    if (threadIdx.x == 0) {
        unsigned* bar = b.bar;
        __builtin_amdgcn_s_waitcnt(0);
        unsigned nloc = b.st[0], nx = b.st[1];
        if (nloc == 0u) { xcd_barrier_complete(bar, b.x, nloc, nx); b.st[0] = nloc; b.st[1] = nx; }
        const unsigned old = xb_add(&bar[XB_XSUB(b.x)], 1u);
        const unsigned gen = old / nloc;
        if (old + 1u == (gen + 1u) * nloc) {
            __builtin_amdgcn_fence(__ATOMIC_RELEASE, "agent");
            asm volatile("s_waitcnt vmcnt(0)" ::: "memory");
            const unsigned og = xb_add(&bar[XB_TOP], 1u);
            const unsigned tg = og / nx;
            if (og + 1u == (tg + 1u) * nx) xb_add(&bar[XB_TOPGEN], 1u);
            else XB_SPIN(xb_ld(&bar[XB_TOPGEN]) == tg, bar);
            __builtin_amdgcn_fence(__ATOMIC_ACQUIRE, "agent");
            xb_add(&bar[XB_XGEN(b.x)], 1u);
            asm volatile("s_waitcnt vmcnt(0)" ::: "memory");
        } else {
            XB_SPIN(xb_ld(&bar[XB_XGEN(b.x)]) == gen, bar);
            __builtin_amdgcn_fence(__ATOMIC_ACQUIRE, "agent");
            asm volatile("s_waitcnt vmcnt(0)" ::: "memory");
        }
    }
    __syncthreads();
}

namespace att {
using bf16x8 = __attribute__((ext_vector_type(8))) short;
using s16x4 = __attribute__((ext_vector_type(4))) short;
using f32x16 = __attribute__((ext_vector_type(16))) float;
constexpr int SHM_V = 16384, SHM_K = 16384;
constexpr int SLOT = SHM_K + SHM_V, NSLOT = 4, OFF_LI = NSLOT * SLOT, ATT_LDS = OFF_LI + 2048;
#define KSWZ(row, colB) ((row) * 256 + ((colB) ^ (((row) & 7) << 4)))
#define SBAR() __builtin_amdgcn_sched_barrier(0)
__device__ __forceinline__ int crow(int r, int hi) { return (r & 3) + 8 * (r >> 2) + 4 * hi; }
__device__ __forceinline__ unsigned cvtpk(float lo, float hi) { return pk2(lo, hi); }
__device__ __forceinline__ int v_st(int k, int c) { const int kk = (k & ~0xC) | ((k & 4) << 1) | ((k & 8) >> 1); return ((kk >> 3) * 4 + (c >> 5)) * 512 + ((kk & 7) * 32 + (c & 31)) * 2; }
__device__ __forceinline__ int v_rd_base(int lane) { return ((lane & 3) << 3) | (((lane >> 2) & 3) << 6) | (((lane >> 4) & 1) << 5) | (((lane >> 5) & 1) << 8); }
constexpr int v_rd_off(int d0, int ks, int half) { return d0 * 512 + ks * 4096 + half * 2048; }
template <int OFF> __device__ __forceinline__ s16x4 tr_read(int vb) { s16x4 r; asm volatile("ds_read_b64_tr_b16 %0, %1 offset:%2" : "=&v"(r) : "v"(vb), "i"(OFF) : "memory"); return r; }
template <int D0> __device__ __forceinline__ void pv_one(f32x16& od, int vb, const bf16x8* pa) {
    const s16x4 l0 = tr_read<v_rd_off(D0, 0, 0)>(vb), h0 = tr_read<v_rd_off(D0, 0, 1)>(vb), l1 = tr_read<v_rd_off(D0, 1, 0)>(vb), h1 = tr_read<v_rd_off(D0, 1, 1)>(vb);
    const s16x4 l2 = tr_read<v_rd_off(D0, 2, 0)>(vb), h2 = tr_read<v_rd_off(D0, 2, 1)>(vb), l3 = tr_read<v_rd_off(D0, 3, 0)>(vb), h3 = tr_read<v_rd_off(D0, 3, 1)>(vb);
    asm volatile("s_waitcnt lgkmcnt(0)" ::: "memory"); SBAR();
#define PK(L, H) (bf16x8){L[0], L[1], L[2], L[3], H[0], H[1], H[2], H[3]}
    od = __builtin_amdgcn_mfma_f32_32x32x16_bf16(pa[0], PK(l0, h0), od, 0, 0, 0);
    od = __builtin_amdgcn_mfma_f32_32x32x16_bf16(pa[1], PK(l1, h1), od, 0, 0, 0);
    od = __builtin_amdgcn_mfma_f32_32x32x16_bf16(pa[2], PK(l2, h2), od, 0, 0, 0);
    od = __builtin_amdgcn_mfma_f32_32x32x16_bf16(pa[3], PK(l3, h3), od, 0, 0, 0);
#undef PK
}
__device__ __forceinline__ void smx(f32x16& p0, f32x16& p1, float& l_acc, bf16x8* pa) {
#pragma unroll
    for (int r = 0; r < 16; ++r) { p0[r] = __builtin_amdgcn_exp2f(p0[r]); p1[r] = __builtin_amdgcn_exp2f(p1[r]); }
    float ps = 0.f;
#pragma unroll
    for (int r = 0; r < 16; ++r) ps += p0[r] + p1[r];
    l_acc += ps;
#define PK4(P, BASE, OUT) do { unsigned a0 = cvtpk(P[BASE + 0], P[BASE + 1]), a1 = cvtpk(P[BASE + 2], P[BASE + 3]);   \
    unsigned b0 = cvtpk(P[BASE + 4], P[BASE + 5]), b1 = cvtpk(P[BASE + 6], P[BASE + 7]);                              \
    auto r0 = __builtin_amdgcn_permlane32_swap(a0, b0, false, false); auto r1 = __builtin_amdgcn_permlane32_swap(a1, b1, false, false); \
    u32x4 w = {r0[0], r1[0], r0[1], r1[1]}; OUT = *reinterpret_cast<bf16x8*>(&w); } while (0)
    PK4(p0, 0, pa[0]); PK4(p0, 8, pa[1]); PK4(p1, 0, pa[2]); PK4(p1, 8, pa[3]);
#undef PK4
}
template <int Q> __device__ __forceinline__ void smxq(f32x16& p0, f32x16& p1, float& l_acc, bf16x8& out) {
    f32x16& P = (Q < 2) ? p0 : p1; constexpr int B = (Q & 1) * 8;
#pragma unroll
    for (int r = 0; r < 8; ++r) P[B + r] = __builtin_amdgcn_exp2f(P[B + r]);
    l_acc += ((P[B + 0] + P[B + 1]) + (P[B + 2] + P[B + 3])) + ((P[B + 4] + P[B + 5]) + (P[B + 6] + P[B + 7]));
    const unsigned a0 = cvtpk(P[B + 0], P[B + 1]), a1 = cvtpk(P[B + 2], P[B + 3]), b0 = cvtpk(P[B + 4], P[B + 5]), b1 = cvtpk(P[B + 6], P[B + 7]);
    auto r0 = __builtin_amdgcn_permlane32_swap(a0, b0, false, false); auto r1 = __builtin_amdgcn_permlane32_swap(a1, b1, false, false);
    u32x4 w = {r0[0], r1[0], r0[1], r1[1]}; out = *reinterpret_cast<bf16x8*>(&w);
}
template <bool DRY> __device__ __forceinline__ void attn_unit(const bf16_t* Qw_, const bf16_t* Kc, const bf16_t* Vc, const bf16_t* Kl, const bf16_t* Vl, int NT,
                                          bf16_t* Ow_, float lam, float negM, const float* subg, float oscale, char* lds, const int wave_s_) {
    const int tid = threadIdx.x, wid = __builtin_amdgcn_readfirstlane(tid >> 6), lane = tid & 63, r32 = lane & 31, hi = lane >> 5, rg = wid & 3, br = wid >> 2;
    float* li = (float*)(lds + OFF_LI) + wid * 64;
    float l_acc = 0.f; f32x16 o[4]; bf16x8 qr[4];
#pragma unroll
    for (int d = 0; d < 4; ++d)
#pragma unroll
        for (int r = 0; r < 16; ++r) o[d][r] = 0.f;
    { const bf16_t* Qw = Qw_ + (size_t)(rg * 32 + r32) * 1024 + br * 64 + hi * 8;
#pragma unroll
      for (int d0 = 0; d0 < 4; ++d0) qr[d0] = *reinterpret_cast<const bf16x8*>(Qw + d0 * 16); }
    int kofs[2], vofs[2];
#pragma unroll
    for (int i = 0; i < 2; ++i) { const int c = 2 * wid + i;
        { const int row = 4 * c + (lane >> 4), colB = ((lane & 15) * 16) ^ ((row & 7) << 4); kofs[i] = row * 1024 + (colB >> 1); }
        { const int sub = 2 * c + (lane >> 5), kk = (sub >> 2) * 8 + ((lane & 31) >> 2), k = (kk & ~0xC) | ((kk & 4) << 1) | ((kk & 8) >> 1), col = (sub & 3) * 32 + (lane & 3) * 8; vofs[i] = k * 1024 + col; } }
    typedef __attribute__((address_space(3))) unsigned las_u32;
    las_u32* ring = (las_u32*)(__attribute__((address_space(3))) char*)lds;
#define DMA_TILE(j, slot) do { const bf16_t* kb_ = ((j) < 4) ? Kc + (size_t)(j) * 65536 : Kl + (size_t)((j) - 4) * 65536; \
    const bf16_t* vb_ = ((j) < 4) ? Vc + (size_t)(j) * 65536 : Vl + (size_t)((j) - 4) * 65536; \
    __builtin_amdgcn_global_load_lds((const unsigned*)(kb_ + kofs[0]), ring + ((slot) * SLOT + (2 * wid) * 1024) / 4, 16, 0, 0); \
    __builtin_amdgcn_global_load_lds((const unsigned*)(kb_ + kofs[1]), ring + ((slot) * SLOT + (2 * wid + 1) * 1024) / 4, 16, 0, 0); \
    __builtin_amdgcn_global_load_lds((const unsigned*)(vb_ + vofs[0]), ring + ((slot) * SLOT + SHM_K + (2 * wid) * 1024) / 4, 16, 0, 0); \
    __builtin_amdgcn_global_load_lds((const unsigned*)(vb_ + vofs[1]), ring + ((slot) * SLOT + SHM_K + (2 * wid + 1) * 1024) / 4, 16, 0, 0); } while (0)
    const int vb0 = (int)(uintptr_t)lds + SHM_K + v_rd_base(lane);
    DMA_TILE(0, 0); DMA_TILE(1, 1);
    asm volatile("s_waitcnt vmcnt(4) lgkmcnt(0)\n\ts_barrier" ::: "memory");
#define QK_TILE(Kt_) do { \
        _Pragma("unroll") for (int r = 0; r < 16; ++r) { p0[r] = negM; p1[r] = negM; } \
        _Pragma("unroll") for (int d0 = 0; d0 < 4; ++d0) { const int cb = (br * 64 + d0 * 16 + hi * 8) * 2; \
            const bf16x8 b0 = *reinterpret_cast<const bf16x8*>((Kt_) + KSWZ(r32, cb)); \
            const bf16x8 b1 = *reinterpret_cast<const bf16x8*>((Kt_) + KSWZ(32 + r32, cb)); \
            p0 = __builtin_amdgcn_mfma_f32_32x32x16_bf16(b0, qr[d0], p0, 0, 0, 0); \
            p1 = __builtin_amdgcn_mfma_f32_32x32x16_bf16(b1, qr[d0], p1, 0, 0, 0); } } while (0)
    bf16x8 pa[4];
    { f32x16 p0, p1; QK_TILE(lds); smx(p0, p1, l_acc, pa); }
    DMA_TILE(2, 2);
    asm volatile("s_waitcnt vmcnt(4) lgkmcnt(0)\n\ts_barrier" ::: "memory");
    int slot = 1;
    for (int j = 1; j < NT; ++j) {
        if (j + 2 < NT) DMA_TILE(j + 2, (slot + 2) & 3);
        const char* Kt = lds + slot * SLOT; const int vbp = vb0 + ((slot + 3) & 3) * SLOT;
        f32x16 p0, p1; bf16x8 pn[4];
        QK_TILE(Kt);
        SBAR();
        pv_one<0>(o[0], vbp, pa); smxq<0>(p0, p1, l_acc, pn[0]); SBAR();
        pv_one<1>(o[1], vbp, pa); smxq<1>(p0, p1, l_acc, pn[1]); SBAR();
        pv_one<2>(o[2], vbp, pa); smxq<2>(p0, p1, l_acc, pn[2]); SBAR();
        pv_one<3>(o[3], vbp, pa); smxq<3>(p0, p1, l_acc, pn[3]); SBAR();
        pa[0] = pn[0]; pa[1] = pn[1]; pa[2] = pn[2]; pa[3] = pn[3];
        if (j + 2 < NT) asm volatile("s_waitcnt vmcnt(4) lgkmcnt(0)\n\ts_barrier" ::: "memory");
        else asm volatile("s_waitcnt vmcnt(0) lgkmcnt(0)\n\ts_barrier" ::: "memory");
        slot = (slot + 1) & 3;
    }
    { const int vbp = vb0 + ((slot + 3) & 3) * SLOT;
      pv_one<0>(o[0], vbp, pa); pv_one<1>(o[1], vbp, pa); pv_one<2>(o[2], vbp, pa); pv_one<3>(o[3], vbp, pa); }
#undef QK_TILE
#undef DMA_TILE
    if constexpr (DRY) { if (o[0][0] == 12345.678f) Ow_[lane] = 0; __syncthreads(); return; }
    { auto rr = __builtin_amdgcn_permlane32_swap(__float_as_uint(l_acc), __float_as_uint(l_acc), false, false); l_acc = __uint_as_float(rr[0]) + __uint_as_float(rr[1]); }
    if (hi == 0) li[r32] = l_acc;
    asm volatile("s_waitcnt lgkmcnt(0)" ::: "memory");
    float* xch = (float*)lds + (size_t)rg * 4096;
    const float lscale = br ? lam : 1.f;
#pragma unroll
    for (int r = 0; r < 16; ++r) { const float a = lscale * __builtin_amdgcn_rcpf(li[crow(r, hi)]);
#pragma unroll
        for (int d = 0; d < 4; ++d) o[d][r] *= a; }
    if (br == 1) {
#pragma unroll
        for (int r = 0; r < 16; ++r)
#pragma unroll
            for (int d = 0; d < 4; ++d) xch[(r * 4 + d) * 64 + lane] = o[d][r];
    }
    __syncthreads();
    if (br == 0) {
        float ss[16];
#pragma unroll
        for (int r = 0; r < 16; ++r) { float s = 0.f;
#pragma unroll
            for (int d = 0; d < 4; ++d) { const float v = o[d][r] - xch[(r * 4 + d) * 64 + lane]; o[d][r] = v; s += v * v; }
            ss[r] = s; }
#pragma unroll
        for (int off = 1; off < 32; off <<= 1)
#pragma unroll
            for (int r = 0; r < 16; ++r) ss[r] += __shfl_xor(ss[r], off);
        float sg[4];
#pragma unroll
        for (int d = 0; d < 4; ++d) sg[d] = subg[d * 32 + r32] * oscale;
        bf16_t* stg = (bf16_t*)(lds + 65536 + rg * 8192);
#pragma unroll
        for (int r = 0; r < 16; ++r) { const float rn = rsqrtf(ss[r] * (1.f / 128.f) + EPS); const int orow = crow(r, hi);
#pragma unroll
            for (int d = 0; d < 4; ++d) stg[orow * 128 + d * 32 + r32] = (bf16_t)f2bf(o[d][r] * rn * sg[d]); }
        asm volatile("s_waitcnt lgkmcnt(0)" ::: "memory");
        bf16_t* Ow = Ow_ + (size_t)(rg * 32) * 1024;
#pragma unroll
        for (int i = 0; i < 8; ++i) { const int row = i * 4 + (lane >> 4), ch = lane & 15;
            const u32x4 v = *(const u32x4*)(stg + row * 128 + ch * 8);
            *(u32x4*)(Ow + (size_t)row * 1024 + ch * 8) = v; }
    }
    __syncthreads();
}
#undef SBAR
}

__device__ __forceinline__ int colmap(int id, int rho) {
    const int local = rho & 255, hi_ = rho & ~255;
    const int s8 = (rho & ~31) | (((rho >> 2) & 3) << 3) | (((rho >> 4) & 1) << 2) | (rho & 3);
    if (id == 2) return s8;
    if (id == 1) return 3584 + s8;
    if (id == 0) { if ((rho >> 10) == 1) return s8; const int bj = local >> 7, wc = (local >> 5) & 3, rest = local & 31; return hi_ + 64 * wc + 32 * bj + rest; }
    { const int pn = rho >> 8, bj = local >> 7; return bj * DFF + 128 * pn + (s8 & 127); }
}
__device__ __forceinline__ void tr_item(const float* W, int K, int N, bf16_t* WT, int nrb, int id, LAS float* scr, int item, int lane) {
    const int kb = item / nrb, rb = item % nrb, k0 = 64 * kb, r0 = 32 * rb;
    const int c = colmap(id, r0 + (lane & 31));
    float wv[32];
#pragma unroll
    for (int i = 0; i < 32; ++i) wv[i] = W[(size_t)(k0 + 2 * i + (lane >> 5)) * N + c];
#pragma unroll
    for (int i = 0; i < 32; ++i) scr[(2 * i + (lane >> 5)) * 33 + (lane & 31)] = wv[i];
    asm volatile("s_waitcnt lgkmcnt(0)" ::: "memory");
    const int ch = lane & 7;
#pragma unroll
    for (int j = 0; j < 4; ++j) { const int n = (lane >> 3) + 8 * j; const LAS float* s = scr + (8 * ch) * 33 + n;
        u32x4 o; o.x = pk2(s[0 * 33], s[1 * 33]); o.y = pk2(s[2 * 33], s[3 * 33]); o.z = pk2(s[4 * 33], s[5 * 33]); o.w = pk2(s[6 * 33], s[7 * 33]);
        *(u32x4*)(WT + (size_t)(r0 + n) * K + k0 + 8 * ch) = o; }
    asm volatile("s_waitcnt lgkmcnt(0)" ::: "memory");
}

struct Args { const float* in[21]; float* out; unsigned char* ws; int ph_lo, ph_hi; };
enum { I_X = 0, I_C, I_CTX, I_CCTX, I_WADA, I_BADA, I_N1G, I_N2G, I_WIN, I_QNG, I_KNG, I_LQ1, I_LK1, I_LQ2, I_LK2, I_SUBG, I_WPA, I_WPF, I_WOUT, I_WGU, I_WD };
constexpr int N_PHASES = 19;
#ifndef ONLY_S
#define ONLY_S -1
#endif
constexpr int only_s = ONLY_S;
#define PS(n) ((only_s < 0 || only_s == (n)) && s == (n))

__device__ __forceinline__ void norm_rows(const float* lat, const float* ctx, const float* g, const float* mod, int shidx, int scidx, bf16_t* H, int M, int gw, int NGW, int lane, const float* PP = nullptr, const float* pgate = nullptr) {
    for (int row = gw; row < M; row += NGW) {
        const float* src = row < M_LAT ? lat + (size_t)row * 1024 : ctx + (size_t)(row - M_LAT) * 1024;
        const int modrow = row < M_LAT ? (row >> 11) : 16;
        const f32x4* xr = (const f32x4*)src + lane;
        f32x4 v[4]; float ss = 0.f;
#pragma unroll
        for (int j = 0; j < 4; ++j) { v[j] = xr[64 * j];
            if (PP && row >= M_LAT) { const f32x4* pa = (const f32x4*)(PP + (size_t)(row - M_LAT) * 1024) + lane; const f32x4* pb = pa + (size_t)M_CTX * 256;
                v[j] += *((const f32x4*)pgate + lane + 64 * j) * (pa[64 * j] + pb[64 * j]); }
            ss += (v[j].x * v[j].x + v[j].y * v[j].y) + (v[j].z * v[j].z + v[j].w * v[j].w); }
        const float rinv = rsqrtf(wave_sum(ss) * (1.f / 1024.f) + EPS);
        const float* mr = mod + (size_t)modrow * 6144;
        u32x2* o8 = (u32x2*)(H + (size_t)row * 1024) + lane;
#pragma unroll
        for (int j = 0; j < 4; ++j) { const int col = 4 * (lane + 64 * j);
            const f32x4 gg = *(const f32x4*)(g + col), sc = *(const f32x4*)(mr + scidx * 1024 + col), sh = *(const f32x4*)(mr + shidx * 1024 + col);
            const f32x4 h = v[j] * rinv * gg * (sc + 1.f) + sh;
            u32x2 w; w.x = pk2(h.x, h.y); w.y = pk2(h.z, h.w); o8[64 * j] = w; }
    }
}

#ifndef MK_XBAR
#define MK_XBAR 1
#endif
#ifndef MK_SP2
#define MK_SP2 false
#endif
#ifndef MK_ALIGN
#define MK_ALIGN false
#endif
#ifndef MK_ALIGN_RES
#define MK_ALIGN_RES MK_ALIGN
#endif
#ifndef MK_ALIGN_KVQ
#define MK_ALIGN_KVQ MK_ALIGN
#endif
struct Ctx { int G, bx, vcu, gw, NGW, lane, tid, wave; };

typedef const __attribute__((address_space(4))) Args* KArgP;
#define KARGS() ((KArgP)__builtin_amdgcn_kernarg_segment_ptr())
template <int PART> __device__ __forceinline__ void p0_phase(LAS unsigned char* lds3, const Ctx& c) {
    KArgP ap = KARGS();
    unsigned char* ws = ap->ws; const int tid = c.tid, lane = c.lane, wave = c.wave, G = c.G, vcu = c.vcu;
    float* SM = (float*)(ws + OFF_LAM); float* ROPE = (float*)(ws + OFF_ROPE); float* MOD = (float*)(ws + OFF_MOD);
    bf16_t* DFT = (bf16_t*)(ws + WS_DFT); bf16_t* DFTC = (bf16_t*)(ws + WS_DFTC);
    LAS float* tab = (LAS float*)(lds3 + 110592);
    if constexpr (PART == 1) {
    for (int i = tid; i < 2048; i += 512) tab[i] = cospif((float)i * (1.f / 1024.f));
    __syncthreads();
#ifndef SKIP_P0A
    { LAS float* scr = (LAS float*)(lds3 + wave * 8448);
      constexpr int PER_L = 8064;
      for (int it = c.gw; it < 2 * PER_L; it += c.NGW) {
          const int l = it / PER_L; int r = it % PER_L;
          unsigned char* wl = ws + WS_W + (size_t)l * W_LSTRIDE;
          const float* win = ap->in[I_WIN] + (size_t)l * 1024 * INW;
          if (r < 1536) { tr_item(win, 1024, INW, (bf16_t*)(wl + W_KVQ), 96, 0, scr, r, lane); continue; } r -= 1536;
          if (r < 1024) { tr_item(win, 1024, INW, (bf16_t*)(wl + W_G), 64, 1, scr, r, lane); continue; } r -= 1024;
          if (r < 512) { tr_item(ap->in[I_WPA] + (size_t)l * 1024 * 1024, 1024, 1024, (bf16_t*)(wl + W_PA), 32, 2, scr, r, lane); continue; } r -= 512;
          if (r < 256) { tr_item(ap->in[I_WPF] + (size_t)l * 512 * 1024, 512, 1024, (bf16_t*)(wl + W_PF), 32, 2, scr, r, lane); continue; } r -= 256;
          if (r < 512) { tr_item(ap->in[I_WOUT] + (size_t)l * 1024 * 1024, 1024, 1024, (bf16_t*)(wl + W_OUT), 32, 2, scr, r, lane); continue; } r -= 512;
          if (r < 2816) { tr_item(ap->in[I_WGU] + (size_t)l * 1024 * 2 * DFF, 1024, 2 * DFF, (bf16_t*)(wl + W_GU), 176, 3, scr, r, lane); continue; } r -= 2816;
          tr_item(ap->in[I_WD] + (size_t)l * DFF * 1024, DFF, 1024, (bf16_t*)(wl + W_D), 32, 2, scr, r, lane);
      } }
    __syncthreads();
#endif
#ifndef SKIP_P0B
    { LAS float* wt = (LAS float*)lds3;
      for (int it = vcu; it < 256; it += G) {
          const int l = it >> 7, g = (it >> 5) & 3, kb = it & 31, k0 = kb * 32;
          const float* win = ap->in[I_WIN] + (size_t)l * 1024 * INW + 3072 + g * 128;
          for (int i = tid; i < 32 * 128; i += 512) { const int kk = i >> 7, cc = i & 127; wt[kk * 129 + cc] = win[(size_t)(k0 + kk) * INW + cc]; }
          __syncthreads();
          bf16_t* wf = (bf16_t*)(ws + WS_W + (size_t)l * W_LSTRIDE + W_F);
          const int kk = tid & 31, cg0 = (tid >> 5) * 4;
          for (int cc = 0; cc < 4; ++cc) { const int cp = cg0 + cc; float ac = 0.f, as = 0.f, a64 = 0.f;
              for (int ci = 0; ci < 128; ++ci) { const int idx = ((ci * cp) & 127) * 16; const float w = wt[kk * 129 + ci]; ac += w * tab[idx]; as += w * tab[(idx - 512) & 2047]; a64 += (ci & 1) ? -w : w; }
              const int r = 2 * (g * 64 + cp);
              wf[(size_t)r * 1024 + k0 + kk] = (bf16_t)f2bf(ac * 0.08838834764831845f);
              wf[(size_t)(r + 1) * 1024 + k0 + kk] = (bf16_t)f2bf((cp == 0 ? a64 : as) * 0.08838834764831845f);
              if (l == 0) { bf16_t* wc_ = (bf16_t*)(ws + WS_WFC) + k0 + kk;
                  const unsigned uc = f2bf(ac * 0.08838834764831845f), us = f2bf(as * 0.08838834764831845f);
                  if (cp == 0) { wc_[(size_t)(2 * (g * 128)) * 1024] = (bf16_t)uc; wc_[(size_t)(2 * (g * 128) + 1) * 1024] = 0;
                                 wc_[(size_t)(2 * (g * 128 + 64)) * 1024] = (bf16_t)f2bf(a64 * 0.08838834764831845f); wc_[(size_t)(2 * (g * 128 + 64) + 1) * 1024] = 0; }
                  else { wc_[(size_t)(2 * (g * 128 + cp)) * 1024] = (bf16_t)uc; wc_[(size_t)(2 * (g * 128 + cp) + 1) * 1024] = (bf16_t)us;
                         wc_[(size_t)(2 * (g * 128 + 128 - cp)) * 1024] = (bf16_t)uc; wc_[(size_t)(2 * (g * 128 + 128 - cp) + 1) * 1024] = (bf16_t)(us ^ 0x8000u); } } }
          __syncthreads();
      } }
#endif
#ifndef SKIP_P0C
    { const int gt = vcu * 512 + tid, NGT = G * 512;
      for (int idx = gt; idx < 2048 * (ZK / 8); idx += NGT) { const int tp = idx / (ZK / 8), k8 = (idx % (ZK / 8)) * 8; float v[8];
#pragma unroll
          for (int e = 0; e < 8; ++e) { const int k = k8 + e; float x;
              if (k < 1024) x = tab[(k * tp) & 2047];
              else if (k < 2048) x = -tab[((((k - 1024) * tp) & 2047) - 512) & 2047];
              else if (k == 2048) x = (tp & 1) ? -1.f : 1.f;
              else x = 0.f;
              v[e] = x * 0.022097086912079608f; }
          u32x4 w; w.x = pk2(v[0], v[1]); w.y = pk2(v[2], v[3]); w.z = pk2(v[4], v[5]); w.w = pk2(v[6], v[7]);
          *(u32x4*)(DFT + (size_t)tp * ZK + k8) = w; }
      for (int idx = gt; idx < 256 * 64; idx += NGT) { const int tp = idx >> 6, k8 = (idx & 63) * 8; float v[8];
#pragma unroll
          for (int e = 0; e < 8; ++e) { const int k = k8 + e, cs = k >> 8, t = k & 255, aa = ((t * tp) & 255) * 8; v[e] = (cs ? -tab[(aa - 512) & 2047] : tab[aa]) * 0.0625f; }
          u32x4 w; w.x = pk2(v[0], v[1]); w.y = pk2(v[2], v[3]); w.z = pk2(v[4], v[5]); w.w = pk2(v[6], v[7]);
          *(u32x4*)(DFTC + (size_t)tp * 512 + k8) = w; } }
#endif
    }
    if constexpr (PART == 0) {
#ifndef SKIP_P0D
    if (c.bx == G - 1) {
        for (int i = tid; i < 1024; i += 512) { const int pos = i >> 4, f = i & 15; const float invf = powf(10000.f, -(float)f * (1.f / 16.f)); const float ang = (float)pos * invf;
            ROPE[i] = cosf(ang); ROPE[1024 + i] = sinf(ang); }
        if (tid < 2) { const int l = tid; float s1 = 0.f, s2 = 0.f, mq = 0.f, mk = 0.f;
            for (int i = 0; i < 64; ++i) { s1 += ap->in[I_LQ1][l * 64 + i] * ap->in[I_LK1][l * 64 + i]; s2 += ap->in[I_LQ2][l * 64 + i] * ap->in[I_LK2][l * 64 + i];
                mq = fmaxf(mq, fabsf(ap->in[I_QNG][l * 64 + i])); mk = fmaxf(mk, fabsf(ap->in[I_KNG][l * 64 + i])); }
            const float lam_init = 0.8f - 0.6f * expf(-0.3f * (float)l);
            SM[l] = expf(s1) - expf(s2) + lam_init; SM[2 + l] = -(8.f * mq * mk * LOG2E); SM[4 + l] = lam_init; }
    }
    __syncthreads();
#endif
#ifndef SKIP_P0E
    { LAS float* sl = (LAS float*)lds3;
      LAS float* part = (LAS float*)(lds3 + 69632);
      for (int i = tid; i < 17 * 1024; i += 512) { const int b = i >> 10, k = i & 1023; const float cv = b < 16 ? ap->in[I_C][b * 1024 + k] : ap->in[I_CCTX][k]; sl[i] = cv * sigmoidf_(cv); }
      __syncthreads();
      for (int it = vcu; it < 192; it += G) {
          const int l = it / 96, n0 = (it % 96) * 64;
          const float* wa = ap->in[I_WADA] + (size_t)l * 1024 * 6144 + n0 + lane;
          float acc[17];
#pragma unroll
          for (int b = 0; b < 17; ++b) acc[b] = 0.f;
#pragma unroll 4
          for (int kk = 0; kk < 128; ++kk) { const int k = wave * 128 + kk; const float w = wa[(size_t)k * 6144];
#pragma unroll
              for (int b = 0; b < 17; ++b) acc[b] += w * sl[b * 1024 + k]; }
#pragma unroll
          for (int b = 0; b < 17; ++b) part[(wave * 17 + b) * 64 + lane] = acc[b];
          __syncthreads();
          for (int i = tid; i < 17 * 64; i += 512) { const int b = i >> 6, n = i & 63; float v = ap->in[I_BADA][l * 6144 + n0 + n];
#pragma unroll
              for (int w = 0; w < 8; ++w) v += part[(w * 17 + b) * 64 + n];
              MOD[((size_t)l * 17 + b) * 6144 + n0 + n] = v; }
          __syncthreads();
      } }
#endif
    }
}

template <int L, int S> __device__ __forceinline__ void run_phase(unsigned char* lds, const Ctx& c) {
    KArgP ap = KARGS();
    LAS unsigned char* lds3 = (LAS unsigned char*)lds;
    unsigned char* ws = ap->ws; const int G = c.G, bx = c.bx;
    float* SM = (float*)(ws + OFF_LAM); float* ROPE = (float*)(ws + OFF_ROPE); float* MOD = (float*)(ws + OFF_MOD);
    bf16_t* DFT = (bf16_t*)(ws + WS_DFT); bf16_t* DFTC = (bf16_t*)(ws + WS_DFTC);
    float* RC = (float*)(ws + WS_RC);
    bf16_t* Hb = (bf16_t*)(ws + WS_H); bf16_t* Qb = (bf16_t*)(ws + WS_Q); bf16_t* Kb = (bf16_t*)(ws + WS_K); bf16_t* Vb = (bf16_t*)(ws + WS_V);
    bf16_t* YT = (bf16_t*)(ws + WS_YT); bf16_t* YTC = (bf16_t*)(ws + WS_YTC); bf16_t* FM = (bf16_t*)(ws + WS_FM);
    bf16_t* Gb = Kb;
    bf16_t* ACT = Qb;
    bf16_t* MG = Hb;
    unsigned char* wl = ws + WS_W + (size_t)L * W_LSTRIDE;
    const float* modl = MOD + (size_t)L * 17 * 6144;
    constexpr int Mrows = (L == 0) ? M_ALL : M_LAT;
    const float* rin_lat = (L == 0) ? ap->in[I_X] : ap->out; const float* rin_ctx = (L == 0) ? ap->in[I_CTX] : RC;
    if constexpr (S == 0) {
        if constexpr (L == 1) norm_rows(rin_lat, rin_ctx, ap->in[I_N1G] + L * 1024, modl, 0, 1, Hb, M_ALL, c.gw, c.NGW, c.lane, (const float*)(ws + WS_FM), MOD + (size_t)16 * 6144 + 5 * 1024);
        else norm_rows(rin_lat, rin_ctx, ap->in[I_N1G] + L * 1024, modl, 0, 1, Hb, M_ALL, c.gw, c.NGW, c.lane);
        if constexpr (L == 0) p0_phase<1>(lds3, c);
    } else if constexpr (S == 1) {
        { LAS float* tabl = (LAS float*)(lds3 + 131072);
          for (int i = c.tid; i < 2048; i += 512) tabl[i] = ROPE[i];
          if (c.tid < 64) { tabl[2048 + c.tid] = ap->in[I_KNG][L * 64 + c.tid]; tabl[2112 + c.tid] = ap->in[I_QNG][L * 64 + c.tid]; }
          __syncthreads(); }
        { pg8::Gemm g{Hb, (const bf16_t*)(wl + W_KVQ), M_ALL, 3072, 1024}; pg8::StaticOrder St; St.init(M_ALL, 3072, G, bx);
          ep::EpiKVQ E{Kb, Vb, Qb, (const LAS float*)(lds3 + 131072)};
          pg8::gemm_phase<ep::EpiKVQ, pg8::StaticOrder, MK_ALIGN_KVQ, MK_SP2>(lds3, g, St, E, c.wave); }
        { pg8::Gemm g{(const bf16_t*)(wl + W_F), Hb, 512, M_LAT, 1024}; pg8::StaticOrder St; St.init(512, M_LAT, G, bx);
          ep::EpiYTm E{YT};
          pg8::gemm_phase<ep::EpiYTm, pg8::StaticOrder, MK_ALIGN, MK_SP2, 1>(lds3, g, St, E, c.wave); }
#ifndef NO_CTXG2
        if constexpr (L == 0) {
          pg8::Gemm g{(const bf16_t*)(ws + WS_WFC), Hb + (size_t)M_LAT * 1024, 1024, M_CTX, 1024}; pg8::StaticOrder St; St.init(1024, M_CTX, G, G - 1 - bx);
          ep::EpiYTc E{YTC};
          pg8::gemm_phase<ep::EpiYTc, pg8::StaticOrder, MK_ALIGN, MK_SP2>(lds3, g, St, E, c.wave); }
#endif
        { const bf16_t* Wf = (const bf16_t*)(wl + W_F);
          for (int it = c.gw; it < 16 * 512; it += c.NGW) { const int b = it >> 9, n = it & 511;
              const bf16_t* hrow = Hb + (size_t)(b * 2048 + 1024) * 1024 + c.lane * 16; const int gq = n >> 7, cq = n & 127, cm = cq <= 64 ? cq : 128 - cq; const bf16_t* wrow = Wf + (size_t)(cm == 64 ? 2 * (gq * 64) + 1 : 2 * (gq * 64 + cm)) * 1024 + c.lane * 16;
              const u32x4 h0 = *(const u32x4*)hrow, h1 = *(const u32x4*)(hrow + 8), w0 = *(const u32x4*)wrow, w1 = *(const u32x4*)(wrow + 8);
              float s = 0.f;
#pragma unroll
              for (int e = 0; e < 4; ++e) { s += bflo(h0[e]) * bflo(w0[e]) + bfhi(h0[e]) * bfhi(w0[e]); s += bflo(h1[e]) * bflo(w1[e]) + bfhi(h1[e]) * bfhi(w1[e]); }
              s = wave_sum(s);
              ((unsigned*)(YT + ((size_t)(b * 512 + n)) * ZK + 2048))[c.lane] = (c.lane == 0) ? f2bf(s) : 0u; } }
    } else if constexpr (S == 2) {
#ifndef SKIP_ATT
        const float lam = SM[L], negM = SM[2 + L], lam_init = SM[4 + L];
        constexpr int nunits = 2048 + (L == 0 ? 256 : 0);
        for (int u = c.vcu; u < nunits; u += G) {
            int b, h, qrow0, NT;
            if (u < 2048) { const int bh = u >> 4, qb = u & 15; b = bh >> 3; h = bh & 7; qrow0 = b * SEQ + qb * 128; NT = 36; }
            else { const int uc = u - 2048, bh = uc >> 1; b = bh >> 3; h = bh & 7; qrow0 = M_LAT + b * CTXL + (uc & 1) * 128; NT = 4; }
            const size_t crow0 = (size_t)(M_LAT + b * CTXL) * 1024 + h * 128, lrow0 = (size_t)(b * SEQ) * 1024 + h * 128;
#ifdef DBL_ATT
            att::attn_unit<true>(Qb + (size_t)qrow0 * 1024 + h * 128, Kb + crow0, Vb + crow0, Kb + lrow0, Vb + lrow0, NT,
                           Qb + (size_t)qrow0 * 1024 + h * 128, lam, negM, ap->in[I_SUBG] + L * 128, 1.f - lam_init, (char*)lds, c.wave);
#endif
            att::attn_unit<false>(Qb + (size_t)qrow0 * 1024 + h * 128, Kb + crow0, Vb + crow0, Kb + lrow0, Vb + lrow0, NT,
                           Qb + (size_t)qrow0 * 1024 + h * 128, lam, negM, ap->in[I_SUBG] + L * 128, 1.f - lam_init, (char*)lds, c.wave);
        }
        __syncthreads();
#endif
        { pg8::Gemm g{DFT, YT, 2048, 8192, ZK}; pg8::StaticOrder St; St.init(2048, 8192, G, bx);
          ep::EpiFM E{FM, 0, SEQ};
          pg8::gemm_phase<ep::EpiFM, pg8::StaticOrder, MK_ALIGN, MK_SP2>(lds3, g, St, E, c.wave);
#ifdef DBL_FM
          pg8::gemm_phase<ep::EpiFM, pg8::StaticOrder, MK_ALIGN, MK_SP2>(lds3, g, St, E, c.wave);
#endif
        }
        if constexpr (L == 0) { pg8::Gemm g{DFTC, YTC, 256, 8192, 512}; pg8::StaticOrder St; St.init(256, 8192, G, bx);
          ep::EpiFM E{FM, M_LAT, CTXL};
          pg8::gemm_phase<ep::EpiFM, pg8::StaticOrder, MK_ALIGN, MK_SP2>(lds3, g, St, E, c.wave); }
    } else if constexpr (S == 3) {
        pg8::Gemm g{Hb, (const bf16_t*)(wl + W_G), Mrows, 2048, 1024}; pg8::StaticOrder St; St.init(Mrows, 2048, G, bx);
        ep::EpiGate E{Gb};
        pg8::gemm_phase<ep::EpiGate, pg8::StaticOrder, MK_ALIGN, MK_SP2>(lds3, g, St, E, c.wave);
    } else if constexpr (S == 4) {
        { pg8::Gemm g{Qb, (const bf16_t*)(wl + W_PA), Mrows, 1024, 1024}; pg8::StaticOrder St; St.init(Mrows, 1024, G, bx);
          ep::EpiMerge<false> E{MG, Gb, 0};
          pg8::gemm_phase<ep::EpiMerge<false>, pg8::StaticOrder, MK_ALIGN, MK_SP2>(lds3, g, St, E, c.wave); }
        { pg8::Gemm g{FM, (const bf16_t*)(wl + W_PF), Mrows, 1024, 512}; pg8::StaticOrder St; St.init(Mrows, 1024, G, bx);
          ep::EpiMerge<true> E{MG, Gb, 1024};
          pg8::gemm_phase<ep::EpiMerge<true>, pg8::StaticOrder, MK_ALIGN, MK_SP2>(lds3, g, St, E, c.wave); }
    } else if constexpr (S == 5) {
        pg8::Gemm g{MG, (const bf16_t*)(wl + W_OUT), Mrows, 1024, 1024}; pg8::StaticOrder St; St.init(Mrows, 1024, G, bx);
        ep::EpiRes E{rin_lat, rin_ctx, ap->out, RC, modl + 2 * 1024, 1.f};
        pg8::gemm_phase<ep::EpiRes, pg8::StaticOrder, MK_ALIGN_RES, MK_SP2>(lds3, g, St, E, c.wave);
    } else if constexpr (S == 6) {
        norm_rows(ap->out, RC, ap->in[I_N2G] + L * 1024, modl, 3, 4, Hb, Mrows, c.gw, c.NGW, c.lane);
    } else if constexpr (S == 7) {
        pg8::Gemm g{Hb, (const bf16_t*)(wl + W_GU), Mrows, 2 * DFF, 1024}; pg8::StaticOrder St; St.init(Mrows, 2 * DFF, G, bx);
        ep::EpiGU E{ACT};
        pg8::gemm_phase<ep::EpiGU, pg8::StaticOrder, MK_ALIGN, MK_SP2>(lds3, g, St, E, c.wave);
    } else {
        { pg8::Gemm g{ACT, (const bf16_t*)(wl + W_D), M_LAT, 1024, DFF}; pg8::StaticOrder St; St.init(M_LAT, 1024, G, bx);
          ep::EpiRes E{ap->out, RC, ap->out, RC, modl + 5 * 1024, 1.f};
          pg8::gemm_phase<ep::EpiRes, pg8::StaticOrder, MK_ALIGN_RES, MK_SP2>(lds3, g, St, E, c.wave); }
        if constexpr (L == 0) {
            float* PP = (float*)(ws + WS_FM);
            { pg8::Gemm g{ACT + (size_t)M_LAT * DFF, (const bf16_t*)(wl + W_D), M_CTX, 1024, DFF / 2, DFF}; pg8::StaticOrder St; St.init(M_CTX, 1024, G, G - 1 - bx);
              ep::EpiPart E{PP};
              pg8::gemm_phase<ep::EpiPart, pg8::StaticOrder, MK_ALIGN, MK_SP2>(lds3, g, St, E, c.wave); }
            { pg8::Gemm g{ACT + (size_t)M_LAT * DFF + DFF / 2, (const bf16_t*)(wl + W_D) + DFF / 2, M_CTX, 1024, DFF / 2, DFF}; pg8::StaticOrder St; St.init(M_CTX, 1024, G, (bx + 128) % G);
              ep::EpiPart E{PP + (size_t)M_CTX * 1024};
              pg8::gemm_phase<ep::EpiPart, pg8::StaticOrder, MK_ALIGN, MK_SP2>(lds3, g, St, E, c.wave); }
        }
    }
}

#ifndef NVGPR
#define NVGPR 256
#endif
#ifndef PH_MASK
#define PH_MASK 0x7ffff
#endif
__global__ void __launch_bounds__(512, 2) __attribute__((amdgpu_num_vgpr(NVGPR))) fwd_mega(Args a) {
    extern __shared__ __attribute__((aligned(16))) unsigned char lds[];
    cg::grid_group grid = cg::this_grid();
#define MAKE_CTX() Ctx c; { int t_ = threadIdx.x; asm volatile("" : "+v"(t_)); c.tid = t_; } c.lane = c.tid & 63; c.wave = __builtin_amdgcn_readfirstlane(c.tid >> 6); \
    c.G = gridDim.x; c.bx = blockIdx.x; c.vcu = (c.G % 8 == 0) ? (c.bx % 8) * (c.G / 8) + c.bx / 8 : c.bx; c.gw = c.vcu * 8 + c.wave; c.NGW = c.G * 8;
    const int lo = a.ph_lo, hi = a.ph_hi;
    { int t0_ = threadIdx.x; asm volatile("" : "+v"(t0_)); for (int i = t0_; i < LDS_BYTES / 16; i += 512) ((LAS u32x4*)lds)[i] = (u32x4){0u, 0u, 0u, 0u}; }
    __syncthreads();
    XcdBarrier xbar = xcd_barrier_post((unsigned*)(a.ws + OFF_XBAR), (volatile LAS unsigned*)((LAS unsigned char*)lds + LDS_BYTES - 64));
#ifndef DBL_SYNC
#define DBL_SYNC 0
#endif
#ifndef DBL_MASK
#define DBL_MASK 0
#endif
#define PH(k, body) if (((PH_MASK >> (k)) & 1) && lo <= (k) && (k) < hi) { if ((k) > lo) { if ((k) == 1 || !MK_XBAR) grid.sync(); else { xcd_barrier(xbar); if (DBL_SYNC) { xcd_barrier(xbar); xcd_barrier(xbar); } } } MAKE_CTX(); body; if constexpr (((DBL_MASK >> (k)) & 1) != 0) { __syncthreads(); body; } }
    PH(0, p0_phase<0>((LAS unsigned char*)lds, c))
    PH(1, (run_phase<0, 0>(lds, c)))  PH(2, (run_phase<0, 1>(lds, c)))  PH(3, (run_phase<0, 2>(lds, c)))
    PH(4, (run_phase<0, 3>(lds, c)))  PH(5, (run_phase<0, 4>(lds, c)))  PH(6, (run_phase<0, 5>(lds, c)))
    PH(7, (run_phase<0, 6>(lds, c)))  PH(8, (run_phase<0, 7>(lds, c)))  PH(9, (run_phase<0, 8>(lds, c)))
    PH(10, (run_phase<1, 0>(lds, c))) PH(11, (run_phase<1, 1>(lds, c))) PH(12, (run_phase<1, 2>(lds, c)))
    PH(13, (run_phase<1, 3>(lds, c))) PH(14, (run_phase<1, 4>(lds, c))) PH(15, (run_phase<1, 5>(lds, c)))
    PH(16, (run_phase<1, 6>(lds, c))) PH(17, (run_phase<1, 7>(lds, c))) PH(18, (run_phase<1, 8>(lds, c)))
#undef PH
}


#ifdef PROBE_STOP
__global__ void probe_dump(const bf16_t* A, const bf16_t* B, int bmask, int bshift, const float* F, float* out) {
    for (size_t i = (size_t)blockIdx.x * 256 + threadIdx.x; i < (size_t)M_LAT * 1024; i += (size_t)gridDim.x * 256) {
        float v = 0.f;
        if (A) v += bflo((unsigned)A[i]);
        if (B) { const size_t row = i >> 10, col = i & 1023; v += bflo((unsigned)B[(row << bshift) + (col & bmask)]); }
        if (F) v += F[i & (((size_t)1 << 22) - 1)];
        out[i] = v;
    }
}
__global__ void probe_diff(const bf16_t* A, const bf16_t* B, float* out) {
    for (size_t i = (size_t)blockIdx.x * 256 + threadIdx.x; i < (size_t)M_LAT * 1024; i += (size_t)gridDim.x * 256) out[i] = 1.0e6f * (bflo((unsigned)A[i]) - bflo((unsigned)B[i]));
}
#endif
extern "C" void kernel_launch(void* const* d_in, const int* in_sizes, int n_in, void* d_out, int out_size, void* d_ws, size_t ws_size, hipStream_t stream) {
    static int grid = 0;
    if (grid == 0) {
        if (n_in != 21 || ws_size < WS_END) fprintf(stderr, "kernel_launch: unexpected n_in %d or ws_size %zu (need %zu)\n", n_in, ws_size, (size_t)WS_END);
        int dev = 0, cus = 0, per_cu = 0;
        hipGetDevice(&dev); hipDeviceGetAttribute(&cus, hipDeviceAttributeMultiprocessorCount, dev);
        if (hipFuncSetAttribute((const void*)fwd_mega, hipFuncAttributeMaxDynamicSharedMemorySize, LDS_BYTES) != hipSuccess) fprintf(stderr, "kernel_launch: hipFuncSetAttribute failed\n");
        if (hipOccupancyMaxActiveBlocksPerMultiprocessor(&per_cu, (const void*)fwd_mega, 512, LDS_BYTES) != hipSuccess || per_cu < 1) { fprintf(stderr, "kernel_launch: occupancy query says %d\n", per_cu); per_cu = 1; }
        (void)hipGetLastError();
        grid = cus * 1;
        if (grid <= 0) grid = 256;
    }
    hipMemsetAsync(d_ws, 0, CTL_ZERO_BYTES, stream);
#ifdef DBG_POISON
    hipMemsetAsync((char*)d_ws + CTL_ZERO_BYTES, 0xAA, WS_END - CTL_ZERO_BYTES, stream);
    hipMemsetAsync(d_out, 0xAA, (size_t)M_LAT * 1024 * 4, stream);
#endif
    Args a{};
    for (int i = 0; i < 21; ++i) a.in[i] = (const float*)d_in[i];
    a.out = (float*)d_out; a.ws = (unsigned char*)d_ws;
#if MK_COOP
    a.ph_lo = 0; a.ph_hi = N_PHASES;
    void* args[] = {&a};
    hipError_t e = hipLaunchCooperativeKernel((const void*)fwd_mega, dim3(grid), dim3(512), args, LDS_BYTES, stream);
    if (e != hipSuccess) fprintf(stderr, "kernel_launch: cooperative launch failed: %s (grid %d)\n", hipGetErrorString(e), grid);
#else
#if defined(PROBE_STOP) && PROBE_STOP == 21
    for (int ph = 0; ph < 9; ++ph) { a.ph_lo = ph; a.ph_hi = ph + 1; hipLaunchKernelGGL(fwd_mega, dim3(grid), dim3(512), LDS_BYTES, stream, a); }
    hipMemcpyAsync((char*)d_ws + WS_YT, (char*)d_ws + WS_Q, (size_t)64 * MiB, hipMemcpyDeviceToDevice, stream);
    a.ph_lo = 8; a.ph_hi = 9; hipLaunchKernelGGL(fwd_mega, dim3(grid), dim3(512), LDS_BYTES, stream, a);
    hipLaunchKernelGGL(probe_diff, dim3(2048), dim3(256), 0, stream, (const bf16_t*)((char*)d_ws + WS_Q), (const bf16_t*)((char*)d_ws + WS_YT), (float*)d_out);
#elif defined(PROBE_STOP) && PROBE_STOP >= 100
    for (int ph = 0; ph < PROBE_STOP - 100; ++ph) { a.ph_lo = ph; a.ph_hi = ph + 1; hipLaunchKernelGGL(fwd_mega, dim3(grid), dim3(512), LDS_BYTES, stream, a); }
    hipMemcpyAsync((char*)d_ws + WS_YT, (char*)d_ws + (size_t)PROBE_BUF * MiB, (size_t)64 * MiB, hipMemcpyDeviceToDevice, stream);
    hipMemsetAsync(d_ws, 0, CTL_ZERO_BYTES, stream);
    for (int ph = 0; ph < PROBE_STOP - 100; ++ph) { a.ph_lo = ph; a.ph_hi = ph + 1; hipLaunchKernelGGL(fwd_mega, dim3(grid), dim3(512), LDS_BYTES, stream, a); }
    hipLaunchKernelGGL(probe_diff, dim3(2048), dim3(256), 0, stream, (const bf16_t*)((char*)d_ws + (size_t)PROBE_BUF * MiB), (const bf16_t*)((char*)d_ws + WS_YT), (float*)d_out);
#elif defined(PROBE_STOP)
    for (int ph = 0; ph < (PROBE_STOP == 20 ? 10 : PROBE_STOP); ++ph) { a.ph_lo = ph; a.ph_hi = ph + 1; hipLaunchKernelGGL(fwd_mega, dim3(grid), dim3(512), LDS_BYTES, stream, a); }
    { unsigned char* w = (unsigned char*)d_ws; const bf16_t* A = nullptr; const bf16_t* B = nullptr; const float* F = nullptr; int bmask = 1023, bshift = 10;
      if (PROBE_STOP == 1) { A = (const bf16_t*)(w + WS_W + W_F); B = (const bf16_t*)(w + WS_DFT); bmask = 1023; bshift = 12; F = (const float*)(w + OFF_MOD); }
      if (PROBE_STOP == 2) { A = (const bf16_t*)(w + WS_H); }
      if (PROBE_STOP == 3) { A = (const bf16_t*)(w + WS_K); B = (const bf16_t*)(w + WS_Q); }
      if (PROBE_STOP == 4) { A = (const bf16_t*)(w + WS_Q); B = (const bf16_t*)(w + WS_FM); bmask = 511; bshift = 9; }
      if (PROBE_STOP == 5) { A = (const bf16_t*)(w + WS_K); }
      if (PROBE_STOP == 6) { A = (const bf16_t*)(w + WS_H); }
      if (PROBE_STOP == 8) { A = (const bf16_t*)(w + WS_H); }
      if (PROBE_STOP == 9) { A = (const bf16_t*)(w + WS_Q); }
      if (PROBE_STOP == 11 || PROBE_STOP == 17) { A = (const bf16_t*)(w + WS_H); }
      if (PROBE_STOP == 20) { F = (const float*)(w + WS_RC); }
      if (PROBE_STOP == 12) { A = (const bf16_t*)(w + WS_K); B = (const bf16_t*)(w + WS_Q); }
      if (PROBE_STOP == 13) { A = (const bf16_t*)(w + WS_Q); B = (const bf16_t*)(w + WS_FM); bmask = 511; bshift = 9; }
      if (PROBE_STOP == 14) { A = (const bf16_t*)(w + WS_K); }
      if (PROBE_STOP == 15) { A = (const bf16_t*)(w + WS_H); }
      if (PROBE_STOP == 18) { A = (const bf16_t*)(w + WS_Q); }
      if (PROBE_STOP == 7 || PROBE_STOP == 10 || PROBE_STOP == 16) { }
      else hipLaunchKernelGGL(probe_dump, dim3(2048), dim3(256), 0, stream, A, B, bmask, bshift, F, (float*)d_out); }
#else
    for (int ph = 0; ph < N_PHASES; ++ph) { a.ph_lo = ph; a.ph_hi = ph + 1; hipLaunchKernelGGL(fwd_mega, dim3(grid), dim3(512), LDS_BYTES, stream, a); }
#endif
#endif
}
```
